# Optimizing an MI355X kernel written in HIP

```python
import math
import jax, jax.numpy as jnp
from jax import lax
import numpy as np

D_MODEL = 1024
BATCH = 8
SEQ = 4096
DEPTH = 1

CTX_LEN = 256
GRID_W = 64
MIX_WIDTH = 2 * D_MODEL
CONV_WIDTH = MIX_WIDTH // 2
SSM_WIDTH = MIX_WIDTH - CONV_WIDTH
CONV_TAPS = 31
CONV_PAD = CONV_TAPS // 2
SSM_GROUP = 16
SSM_GROUPS = SSM_WIDTH // SSM_GROUP
SSM_STATE = 64
DT_MIN = 1e-3
DT_MAX = 1e-1
EPS = 1e-6
IN_COLS = 3 * CONV_WIDTH + 2 * SSM_WIDTH
SPLITS = (CONV_WIDTH, 2 * CONV_WIDTH, 3 * CONV_WIDTH, 3 * CONV_WIDTH + SSM_WIDTH)
U_START = 3 * CONV_WIDTH

kernel_name = 'hybrid_conformer_s5_prefix_dit_layer'


def rmsnorm(x, g):
    xf = x.astype(jnp.float32)
    y = xf * lax.rsqrt(jnp.mean(xf * xf, axis=-1, keepdims=True) + EPS)
    return (y * g.astype(jnp.float32)).astype(x.dtype)


def layernorm(x, g, b):
    xf = x.astype(jnp.float32)
    mu = jnp.mean(xf, axis=-1, keepdims=True)
    var = jnp.mean(jnp.square(xf - mu), axis=-1, keepdims=True)
    y = (xf - mu) * lax.rsqrt(var + EPS)
    return (y * g.astype(jnp.float32) + b.astype(jnp.float32)).astype(x.dtype)


def dwconv_latent(v, w, bias):
    bsz, length, ch = v.shape
    rows = length // GRID_W
    half = ch // 2
    vg = v.reshape(bsz, rows, GRID_W, ch)
    dn = ('NHWC', 'HWIO', 'NHWC')
    w_h = w[:, :half].reshape(1, CONV_TAPS, 1, half)
    w_v = w[:, half:].reshape(CONV_TAPS, 1, 1, ch - half)
    y_h = lax.conv_general_dilated(vg[..., :half], w_h, (1, 1), ((0, 0), (CONV_PAD, CONV_PAD)),
                                   dimension_numbers=dn, feature_group_count=half)
    y_v = lax.conv_general_dilated(vg[..., half:], w_v, (1, 1), ((CONV_PAD, CONV_PAD), (0, 0)),
                                   dimension_numbers=dn, feature_group_count=ch - half)
    return jnp.concatenate([y_h, y_v], axis=-1).reshape(bsz, length, ch) + bias


def dwconv_seq(v, w, bias):
    ch = v.shape[-1]
    y = lax.conv_general_dilated(v, w.reshape(CONV_TAPS, 1, ch), (1,), ((CONV_PAD, CONV_PAD),),
                                 dimension_numbers=('NWC', 'WIO', 'NWC'), feature_group_count=ch)
    return y + bias


def conv_branch(val, glu_gate, silu_gate, w_dw, b_dw, ln_g, ln_b, on_grid):
    v = val * jax.nn.sigmoid(glu_gate)
    v = dwconv_latent(v, w_dw, b_dw) if on_grid else dwconv_seq(v, w_dw, b_dw)
    v = jax.nn.silu(layernorm(v, ln_g, ln_b))
    return v * jax.nn.silu(silu_gate)


def s5_discretise(a_re, a_im, log_dt, b_re, b_im):
    lam = lax.complex(a_re.astype(jnp.float32), a_im.astype(jnp.float32))
    dt = jnp.exp(log_dt.astype(jnp.float32))[:, None]
    lam_bar = jnp.exp(lam * dt)
    b_mat = lax.complex(b_re.astype(jnp.float32), b_im.astype(jnp.float32))
    b_bar = ((lam_bar - 1.0) / lam)[..., None] * b_mat
    return lam_bar, b_bar


def _linear_recurrence(e1, e2):
    a1, b1 = e1
    a2, b2 = e2
    return a1 * a2, a2 * b1 + b2


def s5_direction(u4, lam_bar, b_bar, h0, reverse):
    bu = jnp.einsum('blgh,gph->lbgp', u4.astype(jnp.complex64), b_bar)
    if reverse:
        bu = bu[::-1]
    if h0 is not None:
        bu = bu.at[0].add(lam_bar * h0)
    a = jnp.broadcast_to(lam_bar, (bu.shape[0], 1) + lam_bar.shape)
    _, h = lax.associative_scan(_linear_recurrence, (a, bu), axis=0)
    final = h[-1]
    if reverse:
        h = h[::-1]
    return h, final


def s5_readout(h, c_mat):
    return jnp.real(jnp.einsum('lbgp,ghp->blgh', h, c_mat))


def ssm_branch(u, y_f, y_b, silu_gate, d, glu_w, glu_b):
    bsz, length, _ = u.shape
    y = (y_f + y_b).reshape(bsz, length, SSM_WIDTH) + d.astype(jnp.float32) * u.astype(jnp.float32)
    y = jax.nn.gelu(y).astype(u.dtype)
    y = y * jax.nn.sigmoid(y @ glu_w + glu_b)
    return y * jax.nn.silu(silu_gate)


def setup_inputs(seed: int = 0) -> dict:
    key = jax.random.key(seed)
    ks = jax.random.split(key, 24)
    f32 = jnp.float32
    nrm = lambda k, shape, s: jax.random.normal(k, shape, f32) * s
    n_idx = jnp.arange(SSM_STATE, dtype=f32)
    return {
        'x': nrm(ks[0], (BATCH, SEQ, D_MODEL), 1.0),
        'c': nrm(ks[1], (BATCH, D_MODEL), 1.0),
        'ctx': nrm(ks[2], (BATCH, CTX_LEN, D_MODEL), 1.0),
        'c_ctx': nrm(ks[3], (D_MODEL,), 1.0),
        'norm_g': 1.0 + nrm(ks[4], (DEPTH, D_MODEL), 0.02),
        'w_ada': nrm(ks[5], (DEPTH, D_MODEL, 3 * D_MODEL), D_MODEL ** -0.5),
        'b_ada': nrm(ks[6], (DEPTH, 3 * D_MODEL), 0.02),
        'w_in': nrm(ks[7], (DEPTH, D_MODEL, IN_COLS), D_MODEL ** -0.5),
        'conv_dw': nrm(ks[8], (DEPTH, CONV_TAPS, CONV_WIDTH), CONV_TAPS ** -0.5),
        'conv_db': nrm(ks[9], (DEPTH, CONV_WIDTH), 0.02),
        'conv_ln_g': 1.0 + nrm(ks[10], (DEPTH, CONV_WIDTH), 0.02),
        'conv_ln_b': nrm(ks[11], (DEPTH, CONV_WIDTH), 0.02),
        'ssm_a_re': -0.5 + nrm(ks[12], (DEPTH, 2, SSM_GROUPS, SSM_STATE), 0.01),
        'ssm_a_im': math.pi * n_idx + nrm(ks[13], (DEPTH, 2, SSM_GROUPS, SSM_STATE), 0.01),
        'ssm_log_dt': jax.random.uniform(ks[14], (DEPTH, 2, SSM_GROUPS), f32,
                                         math.log(DT_MIN), math.log(DT_MAX)),
        'ssm_b_re': nrm(ks[15], (DEPTH, 2, SSM_GROUPS, SSM_STATE, SSM_GROUP), (2 * SSM_GROUP) ** -0.5),
        'ssm_b_im': nrm(ks[16], (DEPTH, 2, SSM_GROUPS, SSM_STATE, SSM_GROUP), (2 * SSM_GROUP) ** -0.5),
        'ssm_c_re': nrm(ks[17], (DEPTH, 2, SSM_GROUPS, SSM_GROUP, SSM_STATE), SSM_STATE ** -0.5),
        'ssm_c_im': nrm(ks[18], (DEPTH, 2, SSM_GROUPS, SSM_GROUP, SSM_STATE), SSM_STATE ** -0.5),
        'ssm_d': nrm(ks[19], (DEPTH, SSM_WIDTH), 1.0),
        'ssm_glu_w': nrm(ks[20], (DEPTH, SSM_WIDTH, SSM_WIDTH), SSM_WIDTH ** -0.5),
        'ssm_glu_b': nrm(ks[21], (DEPTH, SSM_WIDTH), 0.02),
        'w_out': nrm(ks[22], (DEPTH, MIX_WIDTH, D_MODEL), MIX_WIDTH ** -0.5),
        'final_g': 1.0 + nrm(ks[23], (D_MODEL,), 0.02),
    }


def reference(x, c, ctx, c_ctx, norm_g, w_ada, b_ada, w_in, conv_dw, conv_db, conv_ln_g, conv_ln_b,
              ssm_a_re, ssm_a_im, ssm_log_dt, ssm_b_re, ssm_b_im, ssm_c_re, ssm_c_im, ssm_d,
              ssm_glu_w, ssm_glu_b, w_out, final_g):
    bsz, length, _ = x.shape
    ctx_len = ctx.shape[1]
    s_c = jax.nn.silu(c)
    s_cc = jax.nn.silu(c_ctx)
    xc = ctx
    for i in range(DEPTH):
        last = i == DEPTH - 1
        shift, scale, gate = jnp.split(s_c @ w_ada[i] + b_ada[i], 3, axis=-1)
        shift_c, scale_c, gate_c = jnp.split(s_cc @ w_ada[i] + b_ada[i], 3, axis=-1)
        h = rmsnorm(x, norm_g[i]) * (1.0 + scale[:, None]) + shift[:, None]
        hc = rmsnorm(xc, norm_g[i]) * (1.0 + scale_c) + shift_c

        lam_f, bbar_f = s5_discretise(ssm_a_re[i, 0], ssm_a_im[i, 0], ssm_log_dt[i, 0], ssm_b_re[i, 0], ssm_b_im[i, 0])
        lam_b, bbar_b = s5_discretise(ssm_a_re[i, 1], ssm_a_im[i, 1], ssm_log_dt[i, 1], ssm_b_re[i, 1], ssm_b_im[i, 1])
        cmat_f = lax.complex(ssm_c_re[i, 0].astype(jnp.float32), ssm_c_im[i, 0].astype(jnp.float32))
        cmat_b = lax.complex(ssm_c_re[i, 1].astype(jnp.float32), ssm_c_im[i, 1].astype(jnp.float32))

        if last:
            u_c = hc @ w_in[i][:, U_START:U_START + SSM_WIDTH]
        else:
            p_c = jnp.split(hc @ w_in[i], SPLITS, axis=-1)
            u_c = p_c[3]
        u_c4 = u_c.astype(jnp.float32).reshape(bsz, ctx_len, SSM_GROUPS, SSM_GROUP)
        hc_f, fin_f = s5_direction(u_c4, lam_f, bbar_f, None, False)
        hc_b, fin_b = s5_direction(u_c4, lam_b, bbar_b, None, True)

        p = jnp.split(h @ w_in[i], SPLITS, axis=-1)
        u4 = p[3].astype(jnp.float32).reshape(bsz, length, SSM_GROUPS, SSM_GROUP)
        hf, _ = s5_direction(u4, lam_f, bbar_f, fin_f, False)
        y_f = s5_readout(hf, cmat_f)
        hb, _ = s5_direction(u4, lam_b, bbar_b, fin_b, True)
        y_b = s5_readout(hb, cmat_b)
        conv_out = conv_branch(p[0], p[1], p[2], conv_dw[i], conv_db[i], conv_ln_g[i], conv_ln_b[i], True)
        ssm_out = ssm_branch(p[3], y_f, y_b, p[4], ssm_d[i], ssm_glu_w[i], ssm_glu_b[i])
        mix = jnp.concatenate([conv_out, ssm_out], axis=-1) @ w_out[i]
        x = x + gate[:, None] * mix

        if not last:
            conv_c = conv_branch(p_c[0], p_c[1], p_c[2], conv_dw[i], conv_db[i], conv_ln_g[i], conv_ln_b[i], False)
            ssm_c = ssm_branch(p_c[3], s5_readout(hc_f, cmat_f), s5_readout(hc_b, cmat_b), p_c[4],
                               ssm_d[i], ssm_glu_w[i], ssm_glu_b[i])
            xc = xc + gate_c * (jnp.concatenate([conv_c, ssm_c], axis=-1) @ w_out[i])
    return rmsnorm(x, final_g)
```

```cpp
#include <hip/hip_runtime.h>
#include <hip/hip_bf16.h>
#include <hip/hip_cooperative_groups.h>
#include <cstdio>
namespace cg = cooperative_groups;

#ifndef MEGA
#define MEGA 0
#endif

typedef unsigned short u16;
using bf16x8 = __attribute__((ext_vector_type(8))) short;
using f32x4 = __attribute__((ext_vector_type(4))) float;

constexpr int D_ = 1024, B_ = 8, L_ = 4096, CTX_ = 256;
constexpr int NTOK = B_ * L_;
constexpr int NCTX = B_ * CTX_;
constexpr int G_ = 64, P_ = 64, H_ = 16, T_ = 64;
constexpr int NCH = 68;
constexpr int UROWS = B_ * NCH;
constexpr size_t UGS = (size_t)UROWS * 1024;
constexpr float EPS = 1e-6f;

struct Params {
  const float *x, *c, *ctx, *c_ctx, *norm_g, *w_ada, *b_ada, *w_in, *conv_dw, *conv_db, *conv_ln_g, *conv_ln_b,
      *a_re, *a_im, *log_dt, *b_re, *b_im, *c_re, *c_im, *ssm_d, *glu_w, *glu_b, *w_out, *final_g;
  float* out;
  float *mod, *rowsq, *lam64, *S;
  u16 *WinT, *GluT, *WoutT, *BpowT, *CpowT, *Kc, *Hb, *Hc, *V, *SGC, *SGS, *Ug, *Hp;
};

__device__ __forceinline__ u16 f2bf(float f) {
  unsigned u = __float_as_uint(f);
  u += 0x7fffu + ((u >> 16) & 1u);
  return (u16)(u >> 16);
}
__device__ __forceinline__ float bf2f(u16 h) { return __uint_as_float(((unsigned)h) << 16); }
__device__ __forceinline__ float bflo(unsigned u) { return __uint_as_float(u << 16); }
__device__ __forceinline__ float bfhi(unsigned u) { return __uint_as_float(u & 0xffff0000u); }
__device__ __forceinline__ unsigned pack2(float a, float b) { return (unsigned)f2bf(a) | ((unsigned)f2bf(b) << 16); }
__device__ __forceinline__ float sigmoidf_(float x) { return 1.f / (1.f + __expf(-x)); }
__device__ __forceinline__ float siluf_(float x) { return x * sigmoidf_(x); }
__device__ __forceinline__ float gelu_tanh(float x) {
  float z = 0.7978845608028654f * (x + 0.044715f * x * x * x);
  float t = 1.f - 2.f / (1.f + __expf(2.f * z));
  return 0.5f * x * (1.f + t);
}
__device__ __forceinline__ float wave_sum(float v) {
#pragma unroll
  for (int o = 32; o >= 1; o >>= 1) v += __shfl_xor(v, o);
  return v;
}

__device__ __forceinline__ void lam_pow(float a_re, float a_im, double dt, int e, double& pr, double& pi) {
  double ang = (double)e * dt * (double)a_im;
  double mag = exp((double)e * dt * (double)a_re);
  double s, c;
  sincos(ang, &s, &c);
  pr = mag * c; pi = mag * s;
}
__device__ __forceinline__ void zoh_coef(float a_re, float a_im, double dt, double& cr, double& ci) {
  double lr, li;
  lam_pow(a_re, a_im, dt, 1, lr, li);
  double nr = lr - 1.0, ni = li;
  double dr = (double)a_re, di = (double)a_im;
  double den = dr * dr + di * di;
  cr = (nr * dr + ni * di) / den;
  ci = (ni * dr - nr * di) / den;
}

__device__ __forceinline__ int lds_byte(int r, int c) {
  int st = (r >> 4) * 2 + (c >> 5), rr = r & 15, cc = c & 31, ob = rr * 64 + cc * 2;
  return st * 1024 + (ob ^ (((ob >> 9) & 1) << 5));
}
__device__ __forceinline__ void stage_rc(int b, int& R, int& C) {
  int st = b / 1024, sb = b % 1024, swz = sb ^ (((sb >> 9) & 1) << 5);
  R = (st >> 1) * 16 + swz / 64;
  C = (st & 1) * 32 + (swz % 64) / 2;
}

template <class FA, class FB>
__device__ __forceinline__ void gemm128(FA fa, FB fb, int nk, f32x4 (&acc)[4][4], unsigned char* smem) {
  const int tid = threadIdx.x, wid = tid >> 6, lane = tid & 63, wr = wid >> 1, wc = wid & 1, fr = lane & 15, fq = lane >> 4;
  int R[4], C[4];
#pragma unroll
  for (int i = 0; i < 4; ++i) stage_rc(tid * 16 + i * 4096, R[i], C[i]);
#pragma unroll
  for (int m = 0; m < 4; ++m)
#pragma unroll
    for (int n = 0; n < 4; ++n) acc[m][n] = f32x4{0.f, 0.f, 0.f, 0.f};
  auto stage = [&](int kt, int buf) {
    unsigned char* sa = smem + buf * 32768;
    unsigned char* sb = sa + 16384;
#pragma unroll
    for (int i = 0; i < 4; ++i) {
      int b = tid * 16 + i * 4096;
      __builtin_amdgcn_global_load_lds((const unsigned*)fa(R[i], kt * 64 + C[i]), (unsigned*)(sa + b), 16, 0, 0);
      __builtin_amdgcn_global_load_lds((const unsigned*)fb(R[i], kt * 64 + C[i]), (unsigned*)(sb + b), 16, 0, 0);
    }
  };
  stage(0, 0);
  for (int kt = 0; kt < nk; ++kt) {
    asm volatile("s_waitcnt vmcnt(0)" ::: "memory");
    __syncthreads();
    if (kt + 1 < nk) stage(kt + 1, (kt + 1) & 1);
    const unsigned char* sa = smem + (kt & 1) * 32768;
    const unsigned char* sb = sa + 16384;
#pragma unroll
    for (int k = 0; k < 2; ++k) {
      bf16x8 a[4], b[4];
#pragma unroll
      for (int m = 0; m < 4; ++m) a[m] = *(const bf16x8*)(sa + lds_byte(wr * 64 + m * 16 + fr, k * 32 + fq * 8));
#pragma unroll
      for (int n = 0; n < 4; ++n) b[n] = *(const bf16x8*)(sb + lds_byte(wc * 64 + n * 16 + fr, k * 32 + fq * 8));
#pragma unroll
      for (int m = 0; m < 4; ++m)
#pragma unroll
        for (int n = 0; n < 4; ++n) acc[m][n] = __builtin_amdgcn_mfma_f32_16x16x32_bf16(b[n], a[m], acc[m][n], 0, 0, 0);
    }
  }
  __syncthreads();
}

__device__ void p0_mod(const Params& p, int item, unsigned char* smem) {
  float* s = (float*)smem;
  float* red = s + 9 * 1024;
  const int tid = threadIdx.x;
  for (int i = tid; i < 9 * 1024; i += 256) {
    int r = i >> 10, k = i & 1023;
    float v = (r < 8) ? p.c[r * 1024 + k] : p.c_ctx[k];
    s[i] = siluf_(v);
  }
  __syncthreads();
  const int ks = tid >> 4, cl = tid & 15, j = item * 16 + cl;
  float acc[9];
#pragma unroll
  for (int r = 0; r < 9; ++r) acc[r] = 0.f;
  for (int k = ks * 64; k < ks * 64 + 64; ++k) {
    float w = p.w_ada[(size_t)k * 3072 + j];
#pragma unroll
    for (int r = 0; r < 9; ++r) acc[r] += s[r * 1024 + k] * w;
  }
#pragma unroll
  for (int r = 0; r < 9; ++r) red[(ks * 16 + cl) * 9 + r] = acc[r];
  __syncthreads();
  if (tid < 144) {
    int r = tid >> 4, c2 = tid & 15, jj = item * 16 + c2;
    float a = p.b_ada[jj];
    for (int q = 0; q < 16; ++q) a += red[(q * 16 + c2) * 9 + r];
    p.mod[r * 3072 + jj] = a;
  }
  __syncthreads();
}

template <bool PERM>
__device__ void p0_transpose(const float* src, int N, u16* dst, int Kd, int kt, int nt, unsigned char* smem) {
  float* t = (float*)smem;
  const int tid = threadIdx.x;
#pragma unroll
  for (int i = 0; i < 16; ++i) {
    int e = i * 256 + tid, kr = e >> 6, nc = e & 63;
    t[kr * 65 + nc] = src[(size_t)(kt * 64 + kr) * N + nt * 64 + nc];
  }
  __syncthreads();
  {
    int nl = tid >> 2, kq = tid & 3;
    int n = nt * 64 + nl, np = n;
    if (PERM) {
      if (n < 2048) {
        int sec = n >> 10, ch = n & 1023, tile = ch >> 6, within = ch & 63, ni2 = within >> 4, c = within & 15;
        np = tile * 128 + (ni2 * 2 + sec) * 16 + c;
      }
    }
    unsigned w[8];
#pragma unroll
    for (int q = 0; q < 8; ++q) w[q] = pack2(t[(kq * 16 + q * 2) * 65 + nl], t[(kq * 16 + q * 2 + 1) * 65 + nl]);
    uint4* d = (uint4*)(dst + (size_t)np * Kd + kt * 64 + kq * 16);
    d[0] = make_uint4(w[0], w[1], w[2], w[3]);
    d[1] = make_uint4(w[4], w[5], w[6], w[7]);
  }
  __syncthreads();
}

__device__ void p0_bpow(const Params& p, int item) {
  const int tid = threadIdx.x;
  int dg = item >> 3, nb = item & 7;
  int n = nb * 16 + (tid >> 4), ri = n >> 6, pp = n & 63;
  int d = dg >> 6;
  int s0 = (tid & 15) * 4;
  double dt = exp((double)p.log_dt[dg]);
  float are = p.a_re[dg * 64 + pp], aim = p.a_im[dg * 64 + pp];
  double cr, ci;
  zoh_coef(are, aim, dt, cr, ci);
  const float* br = p.b_re + ((size_t)dg * 64 + pp) * 16;
  const float* bi = p.b_im + ((size_t)dg * 64 + pp) * 16;
  u16* dst = p.BpowT + ((size_t)dg * 128 + n) * 1024 + s0 * 16;
  for (int q = 0; q < 4; ++q) {
    int s = s0 + q;
    int e = (d == 0) ? (63 - s) : s;
    double lr, li;
    lam_pow(are, aim, dt, e, lr, li);
    double wr_ = lr * cr - li * ci, wi_ = lr * ci + li * cr;
    unsigned w[8];
#pragma unroll
    for (int h2 = 0; h2 < 8; ++h2) {
      float v0, v1;
      double b0r = br[h2 * 2], b0i = bi[h2 * 2], b1r = br[h2 * 2 + 1], b1i = bi[h2 * 2 + 1];
      if (ri == 0) { v0 = (float)(wr_ * b0r - wi_ * b0i); v1 = (float)(wr_ * b1r - wi_ * b1i); }
      else         { v0 = (float)(wr_ * b0i + wi_ * b0r); v1 = (float)(wr_ * b1i + wi_ * b1r); }
      w[h2] = pack2(v0, v1);
    }
    uint4* dd = (uint4*)(dst + q * 16);
    dd[0] = make_uint4(w[0], w[1], w[2], w[3]);
    dd[1] = make_uint4(w[4], w[5], w[6], w[7]);
  }
}

__device__ void p0_cpow(const Params& p, int item) {
  const int tid = threadIdx.x;
  int g = item >> 6, t = item & 63;
  int d = tid >> 7, ri = (tid >> 6) & 1, pp = tid & 63;
  int dg = d * 64 + g;
  double dt = exp((double)p.log_dt[dg]);
  float are = p.a_re[dg * 64 + pp], aim = p.a_im[dg * 64 + pp];
  int e = (d == 0) ? (t + 1) : (64 - t);
  double lr, li;
  lam_pow(are, aim, dt, e, lr, li);
  for (int hp = 0; hp < 16; ++hp) {
    double cr = p.c_re[((size_t)dg * 16 + hp) * 64 + pp], ci = p.c_im[((size_t)dg * 16 + hp) * 64 + pp];
    double wr_ = cr * lr - ci * li, wi_ = cr * li + ci * lr;
    float v = (ri == 0) ? (float)wr_ : (float)(-wi_);
    p.CpowT[((size_t)g * 1024 + t * 16 + hp) * 256 + tid] = f2bf(v);
  }
}

__device__ void p0_kc(const Params& p, int item, unsigned char* smem) {
  float* wre = (float*)smem;
  float* wim = wre + 128;
  const int tid = threadIdx.x;
  int g = item / 127, ti = item % 127, tau = ti - 63;
  int e = tau < 0 ? -tau : tau;
  if (tid < 128) {
    int d = tid >> 6, pp = tid & 63;
    int dg = d * 64 + g;
    double dt = exp((double)p.log_dt[dg]);
    float are = p.a_re[dg * 64 + pp], aim = p.a_im[dg * 64 + pp];
    double cr, ci, lr, li;
    zoh_coef(are, aim, dt, cr, ci);
    lam_pow(are, aim, dt, e, lr, li);
    wre[tid] = (float)(lr * cr - li * ci);
    wim[tid] = (float)(lr * ci + li * cr);
  }
  __syncthreads();
  int hp = tid >> 4, h = tid & 15;
  float val = 0.f;
  for (int d = 0; d < 2; ++d) {
    bool use = (tau == 0) || (d == 0 ? tau > 0 : tau < 0);
    if (!use) continue;
    int dg = d * 64 + g;
    const float* cre = p.c_re + ((size_t)dg * 16 + hp) * 64;
    const float* cim = p.c_im + ((size_t)dg * 16 + hp) * 64;
    const float* bre = p.b_re + (size_t)dg * 64 * 16 + h;
    const float* bim = p.b_im + (size_t)dg * 64 * 16 + h;
    for (int pp = 0; pp < 64; ++pp) {
      float wr_ = wre[d * 64 + pp], wi_ = wim[d * 64 + pp];
      float br = bre[pp * 16], bi = bim[pp * 16];
      float xr = wr_ * br - wi_ * bi, xi = wr_ * bi + wi_ * br;
      val += cre[pp] * xr - cim[pp] * xi;
    }
  }
  if (tau == 0 && hp == h) val += p.ssm_d[g * 16 + h];
  p.Kc[((size_t)g * 128 + ti) * 256 + tid] = f2bf(val);
  __syncthreads();
}

__device__ void p0_misc(const Params& p, int item) {
  const int tid = threadIdx.x;
  if (item < 32) {
    int idx = item * 256 + tid;
    int dg = idx >> 6;
    double dt = exp((double)p.log_dt[dg]);
    double lr, li;
    lam_pow(p.a_re[idx], p.a_im[idx], dt, 64, lr, li);
    p.lam64[idx * 2] = (float)lr;
    p.lam64[idx * 2 + 1] = (float)li;
  } else {
    int idx = (item - 32) * 1024 + tid * 4;
    *(float4*)(p.rowsq + idx) = make_float4(0.f, 0.f, 0.f, 0.f);
  }
}

constexpr int P0_MOD = 192, P0_TIN = 16 * 80, P0_TGLU = 16 * 16, P0_TOUT = 32 * 16, P0_BPOW = 1024, P0_CPOW = 4096,
              P0_KC = 64 * 127, P0_MISC = 64;
__device__ void phase0(const Params& p, unsigned char* smem) {
  constexpr int o1 = P0_MOD, o2 = o1 + P0_KC, o3 = o2 + P0_TIN, o4 = o3 + P0_TGLU, o5 = o4 + P0_TOUT, o6 = o5 + P0_BPOW,
                o7 = o6 + P0_CPOW, o8 = o7 + P0_MISC;
  for (int it = blockIdx.x; it < o8; it += gridDim.x) {
    if (it < o1) p0_mod(p, it, smem);
    else if (it < o2) p0_kc(p, it - o1, smem);
    else if (it < o3) { int i = it - o2; p0_transpose<true>(p.w_in, 5120, p.WinT, 1024, i / 80, i % 80, smem); }
    else if (it < o4) { int i = it - o3; p0_transpose<false>(p.glu_w, 1024, p.GluT, 1024, i / 16, i % 16, smem); }
    else if (it < o5) { int i = it - o4; p0_transpose<false>(p.w_out, 1024, p.WoutT, 2048, i / 16, i % 16, smem); }
    else if (it < o6) p0_bpow(p, it - o5);
    else if (it < o7) p0_cpow(p, it - o6);
    else p0_misc(p, it - o7);
  }
}

__device__ void phase1(const Params& p) {
  const int wid = threadIdx.x >> 6, lane = threadIdx.x & 63;
  for (int it = blockIdx.x; it < (NTOK + NCTX) / 4; it += gridDim.x) {
    int r = it * 4 + wid;
    const float* src; u16* dst; int mrow;
    if (r < NTOK) { src = p.x + (size_t)r * 1024; dst = p.Hb + (size_t)r * 1024; mrow = r >> 12; }
    else { int rc = r - NTOK; src = p.ctx + (size_t)rc * 1024; dst = p.Hc + (size_t)rc * 1024; mrow = 8; }
    float4 v[4];
    float ss = 0.f;
#pragma unroll
    for (int i = 0; i < 4; ++i) {
      v[i] = *(const float4*)(src + i * 256 + lane * 4);
      ss += v[i].x * v[i].x + v[i].y * v[i].y + v[i].z * v[i].z + v[i].w * v[i].w;
    }
    ss = wave_sum(ss);
    float rstd = rsqrtf(ss * (1.f / 1024.f) + EPS);
    const float* shift = p.mod + mrow * 3072;
    const float* scale = shift + 1024;
#pragma unroll
    for (int i = 0; i < 4; ++i) {
      int idx = i * 256 + lane * 4;
      float4 g = *(const float4*)(p.norm_g + idx);
      float4 sc = *(const float4*)(scale + idx);
      float4 sh = *(const float4*)(shift + idx);
      float h0 = v[i].x * rstd * g.x * (1.f + sc.x) + sh.x;
      float h1 = v[i].y * rstd * g.y * (1.f + sc.y) + sh.y;
      float h2 = v[i].z * rstd * g.z * (1.f + sc.z) + sh.z;
      float h3 = v[i].w * rstd * g.w * (1.f + sc.w) + sh.w;
      *(uint2*)(dst + idx) = make_uint2(pack2(h0, h1), pack2(h2, h3));
    }
  }
}

__device__ void phase2(const Params& p, unsigned char* smem) {
  const int tid = threadIdx.x, wid = tid >> 6, lane = tid & 63, wr = wid >> 1, wc = wid & 1, fr = lane & 15, fq = lane >> 4;
  constexpr int NMAIN = 256 * 40, NCT = 16 * 8;
  for (int it = blockIdx.x; it < NMAIN + NCT; it += gridDim.x) {
    int mt, nt; const u16* A; bool isctx = it >= NMAIN;
    if (!isctx) { mt = it / 40; nt = it % 40; A = p.Hb; }
    else { int i = it - NMAIN; mt = i >> 3; nt = 24 + (i & 7); A = p.Hc; }
    const u16* Ab = A + (size_t)mt * 128 * 1024;
    const u16* Bb = p.WinT + (size_t)nt * 128 * 1024;
    f32x4 acc[4][4];
    gemm128([&](int R, int k) { return Ab + (size_t)R * 1024 + k; },
            [&](int R, int k) { return Bb + (size_t)R * 1024 + k; }, 16, acc, smem);
#pragma unroll
    for (int mi = 0; mi < 4; ++mi) {
      int m = mt * 128 + wr * 64 + mi * 16 + fr;
      if (nt < 16) {
#pragma unroll
        for (int q = 0; q < 2; ++q) {
          f32x4 va = acc[mi][2 * q], gl = acc[mi][2 * q + 1];
          int ch = nt * 64 + (wc * 2 + q) * 16 + fq * 4;
          float v0 = va[0] * sigmoidf_(gl[0]), v1 = va[1] * sigmoidf_(gl[1]);
          float v2 = va[2] * sigmoidf_(gl[2]), v3 = va[3] * sigmoidf_(gl[3]);
          *(uint2*)(p.V + (size_t)m * 1024 + ch) = make_uint2(pack2(v0, v1), pack2(v2, v3));
        }
      } else if (nt < 24 || nt >= 32) {
        u16* dstb = (nt < 24) ? p.SGC : p.SGS;
        int nb = (nt < 24) ? (nt - 16) : (nt - 32);
#pragma unroll
        for (int ni = 0; ni < 4; ++ni) {
          f32x4 a = acc[mi][ni];
          int ch = nb * 128 + wc * 64 + ni * 16 + fq * 4;
          *(uint2*)(dstb + (size_t)m * 1024 + ch) =
              make_uint2(pack2(siluf_(a[0]), siluf_(a[1])), pack2(siluf_(a[2]), siluf_(a[3])));
        }
      } else {
        size_t tokrow;
        if (!isctx) { int b = m >> 12, l = m & 4095; tokrow = (size_t)b * 4352 + 256 + l; }
        else { int b = m >> 8, l = m & 255; tokrow = (size_t)b * 4352 + l; }
#pragma unroll
        for (int ni = 0; ni < 4; ++ni) {
          f32x4 a = acc[mi][ni];
          int g = (nt - 24) * 8 + wc * 4 + ni;
          *(uint2*)(p.Ug + (size_t)g * UGS + tokrow * 16 + fq * 4) = make_uint2(pack2(a[0], a[1]), pack2(a[2], a[3]));
        }
      }
    }
  }
}

__device__ void p3_conv(const Params& p, int item, unsigned char* smem) {
  const int tid = threadIdx.x, wid = tid >> 6, lane = tid & 63;
  const int b = item >> 6, r = item & 63;
  const size_t tok0 = (size_t)b * 4096 + r * 64;
  float* scr = p.out + tok0 * 1024;
  float2* wl = (float2*)smem;
  for (int half = 0; half < 2; ++half) {
    const int ch = half * 512 + tid * 2;
    __syncthreads();
    for (int k = 0; k < 31; ++k) wl[k * 256 + tid] = *(const float2*)(p.conv_dw + k * 1024 + ch);
    float2 bias = *(const float2*)(p.conv_db + ch);
    const u16* vb = p.V + (size_t)b * 4096 * 1024 + ch;
    for (int q = 0; q < 64; ++q) {
      float a0 = bias.x, a1 = bias.y;
      const int pos = half ? r : q;
      const int klo = (15 - pos) > 0 ? (15 - pos) : 0;
      const int khi = (79 - pos) < 31 ? (79 - pos) : 31;
      const int tokbase = half ? ((r - 15) * 64 + q) : (r * 64 + q - 15);
      const int tstride = half ? 64 : 1;
#pragma unroll 4
      for (int k = klo; k < khi; ++k) {
        unsigned t = *(const unsigned*)(vb + (size_t)(tokbase + k * tstride) * 1024);
        float2 w = wl[k * 256 + tid];
        a0 += bflo(t) * w.x; a1 += bfhi(t) * w.y;
      }
      *(float2*)(scr + (size_t)q * 1024 + ch) = make_float2(a0, a1);
    }
  }
  __syncthreads();
  for (int q = wid * 16; q < wid * 16 + 16; ++q) {
    const float* src = scr + (size_t)q * 1024;
    u16* gd = p.SGC + (tok0 + q) * 1024;
    float4 v[4];
    float s = 0.f;
#pragma unroll
    for (int i = 0; i < 4; ++i) {
      v[i] = *(const float4*)(src + i * 256 + lane * 4);
      s += v[i].x + v[i].y + v[i].z + v[i].w;
    }
    s = wave_sum(s);
    float mu = s * (1.f / 1024.f);
    float ss = 0.f;
#pragma unroll
    for (int i = 0; i < 4; ++i) {
      float d0 = v[i].x - mu, d1 = v[i].y - mu, d2 = v[i].z - mu, d3 = v[i].w - mu;
      ss += d0 * d0 + d1 * d1 + d2 * d2 + d3 * d3;
    }
    ss = wave_sum(ss);
    float rstd = rsqrtf(ss * (1.f / 1024.f) + EPS);
#pragma unroll
    for (int i = 0; i < 4; ++i) {
      int idx = i * 256 + lane * 4;
      float4 g = *(const float4*)(p.conv_ln_g + idx);
      float4 bb = *(const float4*)(p.conv_ln_b + idx);
      uint2 gt = *(const uint2*)(gd + idx);
      float y0 = siluf_((v[i].x - mu) * rstd * g.x + bb.x) * bflo(gt.x);
      float y1 = siluf_((v[i].y - mu) * rstd * g.y + bb.y) * bfhi(gt.x);
      float y2 = siluf_((v[i].z - mu) * rstd * g.z + bb.z) * bflo(gt.y);
      float y3 = siluf_((v[i].w - mu) * rstd * g.w + bb.w) * bfhi(gt.y);
      *(uint2*)(gd + idx) = make_uint2(pack2(y0, y1), pack2(y2, y3));
    }
  }
  __syncthreads();
}

__device__ void phase3(const Params& p, unsigned char* smem) {
  const int tid = threadIdx.x, wid = tid >> 6, lane = tid & 63, wr = wid >> 1, wc = wid & 1, fr = lane & 15, fq = lane >> 4;
  constexpr int NCONV = 512, NST = 2 * 64 * 5;
  for (int it = blockIdx.x; it < NCONV + NST; it += gridDim.x) {
    if (it < NCONV) { p3_conv(p, it, smem); continue; }
    int i = it - NCONV;
    int mt = i % 5, dg = i / 5, g = dg & 63;
    const u16* Ab = p.Ug + (size_t)g * UGS + (size_t)mt * 128 * 1024;
    const u16* Bb = p.BpowT + (size_t)dg * 128 * 1024;
    f32x4 acc[4][4];
    gemm128([&](int R, int k) { return Ab + (size_t)R * 1024 + k; },
            [&](int R, int k) { return Bb + (size_t)R * 1024 + k; }, 16, acc, smem);
#pragma unroll
    for (int mi = 0; mi < 4; ++mi) {
      int row = mt * 128 + wr * 64 + mi * 16 + fr;
      if (row < UROWS) {
#pragma unroll
        for (int ni = 0; ni < 4; ++ni) {
          int n = wc * 64 + ni * 16 + fq * 4;
          f32x4 a = acc[mi][ni];
          *(float4*)(p.S + ((size_t)dg * UROWS + row) * 128 + n) = make_float4(a[0], a[1], a[2], a[3]);
        }
      }
    }
  }
}

__device__ void phase4(const Params& p) {
  const int tid = threadIdx.x;
  for (int it = blockIdx.x; it < 256; it += gridDim.x) {
    int idx = it * 4 + (tid >> 6), pp = tid & 63;
    int d = idx >> 9, b = (idx >> 6) & 7, g = idx & 63;
    int dg = d * 64 + g;
    float lr = p.lam64[(dg * 64 + pp) * 2], li = p.lam64[(dg * 64 + pp) * 2 + 1];
    float hr = 0.f, hi = 0.f;
    const float* Sb = p.S + ((size_t)dg * UROWS + b * NCH) * 128;
    u16* Hb = p.Hp + ((size_t)g * 512 + b * 64) * 256 + d * 128;
#pragma unroll 4
    for (int step = 0; step < NCH; ++step) {
      int c = (d == 0) ? step : (step < 4 ? 3 - step : 71 - step);
      if (c >= 4) {
        Hb[(size_t)(c - 4) * 256 + pp] = f2bf(hr);
        Hb[(size_t)(c - 4) * 256 + 64 + pp] = f2bf(hi);
      }
      float sr = Sb[(size_t)c * 128 + pp], si = Sb[(size_t)c * 128 + 64 + pp];
      float nr = lr * hr - li * hi + sr;
      float ni = lr * hi + li * hr + si;
      hr = nr; hi = ni;
    }
  }
}

__device__ void phase5(const Params& p, unsigned char* smem) {
  const int tid = threadIdx.x, wid = tid >> 6, lane = tid & 63, wr = wid >> 1, wc = wid & 1, fr = lane & 15, fq = lane >> 4;
  u16* Yact = p.Hb;
  for (int it = blockIdx.x; it < 64 * 32; it += gridDim.x) {
    int nt = it & 7, mt = (it >> 3) & 3, g = it >> 5;
    const u16* Ug = p.Ug + (size_t)g * UGS;
    const u16* Hp = p.Hp + ((size_t)g * 512 + mt * 128) * 256;
    const u16* Kc = p.Kc + (size_t)g * 128 * 256;
    const u16* Cp = p.CpowT + ((size_t)g * 1024 + nt * 128) * 256;
    f32x4 acc[4][4];
    gemm128(
        [&](int R, int k) -> const u16* {
          if (k < 1024) { int rr = mt * 128 + R; int row = (rr >> 6) * NCH + 4 + (rr & 63); return Ug + (size_t)row * 1024 + k; }
          return Hp + (size_t)R * 256 + (k - 1024);
        },
        [&](int R, int k) -> const u16* {
          if (k < 1024) { int n = nt * 128 + R; int t = n >> 4, hp = n & 15, s = k >> 4, h = k & 15; return Kc + ((t - s + 63) * 16 + hp) * 16 + h; }
          return Cp + (size_t)R * 256 + (k - 1024);
        },
        20, acc, smem);
#pragma unroll
    for (int mi = 0; mi < 4; ++mi) {
      int rr = mt * 128 + wr * 64 + mi * 16 + fr;
      int b = rr >> 6, cc = rr & 63;
#pragma unroll
      for (int ni = 0; ni < 4; ++ni) {
        int t = nt * 8 + wc * 4 + ni;
        size_t tok = (size_t)b * 4096 + cc * 64 + t;
        f32x4 a = acc[mi][ni];
        *(uint2*)(Yact + tok * 1024 + g * 16 + fq * 4) =
            make_uint2(pack2(gelu_tanh(a[0]), gelu_tanh(a[1])), pack2(gelu_tanh(a[2]), gelu_tanh(a[3])));
      }
    }
  }
}

__device__ void phase6(const Params& p, unsigned char* smem) {
  const int tid = threadIdx.x, wid = tid >> 6, lane = tid & 63, wr = wid >> 1, wc = wid & 1, fr = lane & 15, fq = lane >> 4;
  const u16* Yact = p.Hb;
  for (int it = blockIdx.x; it < 256 * 8; it += gridDim.x) {
    int nt = it & 7, mt = it >> 3;
    const u16* Ab = Yact + (size_t)mt * 128 * 1024;
    const u16* Bb = p.GluT + (size_t)nt * 128 * 1024;
    f32x4 acc[4][4];
    gemm128([&](int R, int k) { return Ab + (size_t)R * 1024 + k; },
            [&](int R, int k) { return Bb + (size_t)R * 1024 + k; }, 16, acc, smem);
#pragma unroll
    for (int mi = 0; mi < 4; ++mi) {
      int m = mt * 128 + wr * 64 + mi * 16 + fr;
#pragma unroll
      for (int ni = 0; ni < 4; ++ni) {
        int n = nt * 128 + wc * 64 + ni * 16 + fq * 4;
        f32x4 a = acc[mi][ni];
        float4 gb = *(const float4*)(p.glu_b + n);
        uint2 y = *(const uint2*)(Yact + (size_t)m * 1024 + n);
        uint2 s = *(const uint2*)(p.SGS + (size_t)m * 1024 + n);
        float o0 = bflo(y.x) * sigmoidf_(a[0] + gb.x) * bflo(s.x);
        float o1 = bfhi(y.x) * sigmoidf_(a[1] + gb.y) * bfhi(s.x);
        float o2 = bflo(y.y) * sigmoidf_(a[2] + gb.z) * bflo(s.y);
        float o3 = bfhi(y.y) * sigmoidf_(a[3] + gb.w) * bfhi(s.y);
        *(uint2*)(p.SGS + (size_t)m * 1024 + n) = make_uint2(pack2(o0, o1), pack2(o2, o3));
      }
    }
  }
}

__device__ void phase7(const Params& p, unsigned char* smem) {
  const int tid = threadIdx.x, wid = tid >> 6, lane = tid & 63, wr = wid >> 1, wc = wid & 1, fr = lane & 15, fq = lane >> 4;
  for (int it = blockIdx.x; it < 256 * 8; it += gridDim.x) {
    int nt = it & 7, mt = it >> 3;
    const u16* A0 = p.SGC + (size_t)mt * 128 * 1024;
    const u16* A1 = p.SGS + (size_t)mt * 128 * 1024;
    const u16* Bb = p.WoutT + (size_t)nt * 128 * 2048;
    f32x4 acc[4][4];
    gemm128([&](int R, int k) -> const u16* { return (k < 1024) ? (A0 + (size_t)R * 1024 + k) : (A1 + (size_t)R * 1024 + (k - 1024)); },
            [&](int R, int k) { return Bb + (size_t)R * 2048 + k; }, 32, acc, smem);
#pragma unroll
    for (int mi = 0; mi < 4; ++mi) {
      int m = mt * 128 + wr * 64 + mi * 16 + fr;
      const float* gate = p.mod + (m >> 12) * 3072 + 2048;
      float sq = 0.f;
#pragma unroll
      for (int ni = 0; ni < 4; ++ni) {
        int n = nt * 128 + wc * 64 + ni * 16 + fq * 4;
        f32x4 a = acc[mi][ni];
        float4 xv = *(const float4*)(p.x + (size_t)m * 1024 + n);
        float4 gt = *(const float4*)(gate + n);
        float o0 = xv.x + gt.x * a[0], o1 = xv.y + gt.y * a[1], o2 = xv.z + gt.z * a[2], o3 = xv.w + gt.w * a[3];
        sq += o0 * o0 + o1 * o1 + o2 * o2 + o3 * o3;
        *(float4*)(p.out + (size_t)m * 1024 + n) = make_float4(o0, o1, o2, o3);
      }
      sq += __shfl_xor(sq, 16);
      sq += __shfl_xor(sq, 32);
      if (fq == 0) atomicAdd(p.rowsq + m, sq);
    }
  }
}

__device__ void phase8(const Params& p) {
  const int wid = threadIdx.x >> 6, lane = threadIdx.x & 63;
  for (int it = blockIdx.x; it < NTOK / 4; it += gridDim.x) {
    int r = it * 4 + wid;
    float rstd = rsqrtf(p.rowsq[r] * (1.f / 1024.f) + EPS);
    float* row = p.out + (size_t)r * 1024;
#pragma unroll
    for (int i = 0; i < 4; ++i) {
      int idx = i * 256 + lane * 4;
      float4 v = *(const float4*)(row + idx);
      float4 g = *(const float4*)(p.final_g + idx);
      *(float4*)(row + idx) = make_float4(v.x * rstd * g.x, v.y * rstd * g.y, v.z * rstd * g.z, v.w * rstd * g.w);
    }
  }
}

template <int PH>
__device__ __forceinline__ void run_phase(const Params& p, unsigned char* smem) {
  if (PH == 0) phase0(p, smem);
  if (PH == 1) phase1(p);
  if (PH == 2) phase2(p, smem);
  if (PH == 3) phase3(p, smem);
  if (PH == 4) phase4(p);
  if (PH == 5) phase5(p, smem);
  if (PH == 6) phase6(p, smem);
  if (PH == 7) phase7(p, smem);
  if (PH == 8) phase8(p);
}

#if MEGA
__global__ void __launch_bounds__(256, 2) mega_kernel(Params p) {
  __shared__ __attribute__((aligned(16))) unsigned char smem[65536];
  cg::grid_group grid = cg::this_grid();
  run_phase<0>(p, smem); grid.sync();
  run_phase<1>(p, smem); grid.sync();
  run_phase<2>(p, smem); grid.sync();
  run_phase<3>(p, smem); grid.sync();
  run_phase<4>(p, smem); grid.sync();
  run_phase<5>(p, smem); grid.sync();
  run_phase<6>(p, smem); grid.sync();
  run_phase<7>(p, smem); grid.sync();
  run_phase<8>(p, smem);
}
#else
template <int PH>
__global__ void __launch_bounds__(256, 2) phase_kernel(Params p) {
  __shared__ __attribute__((aligned(16))) unsigned char smem[65536];
  run_phase<PH>(p, smem);
}
#endif

static size_t align_up(size_t v) { return (v + 255) & ~(size_t)255; }

extern "C" void kernel_launch(void* const* d_in, const int* in_sizes, int n_in, void* d_out, int out_size, void* d_ws,
                              size_t ws_size, hipStream_t stream) {
  Params p{};
  const float** pin = (const float**)&p;
  for (int i = 0; i < 24; ++i) pin[i] = (const float*)d_in[i];
  p.out = (float*)d_out;
  unsigned char* w = (unsigned char*)d_ws;
  size_t off = 0;
  auto take = [&](size_t bytes) { unsigned char* r = w + off; off = align_up(off + bytes); return r; };
  p.mod = (float*)take(9 * 3072 * 4);
  p.rowsq = (float*)take((size_t)NTOK * 4);
  p.lam64 = (float*)take(2 * 64 * 64 * 2 * 4);
  p.WinT = (u16*)take((size_t)5120 * 1024 * 2);
  p.GluT = (u16*)take((size_t)1024 * 1024 * 2);
  p.WoutT = (u16*)take((size_t)1024 * 2048 * 2);
  p.BpowT = (u16*)take((size_t)2 * 64 * 128 * 1024 * 2);
  p.CpowT = (u16*)take((size_t)64 * 1024 * 256 * 2);
  p.Kc = (u16*)take((size_t)64 * 128 * 256 * 2);
  p.Hb = (u16*)take((size_t)NTOK * 1024 * 2);
  p.Hc = (u16*)take((size_t)NCTX * 1024 * 2);
  p.V = (u16*)take((size_t)NTOK * 1024 * 2);
  p.SGC = (u16*)take((size_t)NTOK * 1024 * 2);
  p.SGS = (u16*)take((size_t)NTOK * 1024 * 2);
  p.Ug = (u16*)take((size_t)64 * UGS * 2);
  p.S = (float*)take((size_t)2 * 64 * UROWS * 128 * 4);
  p.Hp = (u16*)take((size_t)64 * 512 * 256 * 2);
  if (off > ws_size) { fprintf(stderr, "kernel_launch: workspace too small: need %zu have %zu\n", off, ws_size); return; }
#if MEGA
  static int grid = 0;
  if (!grid) {
    int dev = 0, cus = 0, per_cu = 0;
    hipGetDevice(&dev);
    hipDeviceGetAttribute(&cus, hipDeviceAttributeMultiprocessorCount, dev);
    hipOccupancyMaxActiveBlocksPerMultiprocessor(&per_cu, (const void*)mega_kernel, 256, 0);
    if (per_cu < 1) per_cu = 1;
    if (per_cu > 2) per_cu = 2;
    grid = cus * per_cu;
  }
  void* args[] = {&p};
  hipError_t e = hipLaunchCooperativeKernel((const void*)mega_kernel, dim3(grid), dim3(256), args, 0, stream);
  if (e != hipSuccess) fprintf(stderr, "cooperative launch failed: %s (grid %d)\n", hipGetErrorString(e), grid);
#else
  const int grid = 512;
  phase_kernel<0><<<grid, 256, 0, stream>>>(p);
  phase_kernel<1><<<grid, 256, 0, stream>>>(p);
  phase_kernel<2><<<grid, 256, 0, stream>>>(p);
  phase_kernel<3><<<grid, 256, 0, stream>>>(p);
  phase_kernel<4><<<grid, 256, 0, stream>>>(p);
  phase_kernel<5><<<grid, 256, 0, stream>>>(p);
  phase_kernel<6><<<grid, 256, 0, stream>>>(p);
  phase_kernel<7><<<grid, 256, 0, stream>>>(p);
  phase_kernel<8><<<grid, 256, 0, stream>>>(p);
#endif
}
```

```cpp
#include <hip/hip_runtime.h>
#include <hip/hip_bf16.h>
#include <hip/hip_cooperative_groups.h>
#include <cstdio>
namespace cg = cooperative_groups;

#ifndef MEGA
#define MEGA 1
#endif

#ifndef PROBE
#define PROBE -1
#endif
typedef unsigned short u16;
using bf16x8 = __attribute__((ext_vector_type(8))) short;
using f32x4 = __attribute__((ext_vector_type(4))) float;

constexpr int D_ = 1024, B_ = 8, L_ = 4096, CTX_ = 256;
constexpr int NTOK = B_ * L_;
constexpr int NCTX = B_ * CTX_;
constexpr int G_ = 64, P_ = 64, H_ = 16, T_ = 64;
constexpr int NCH = 68;
constexpr int UROWS = B_ * NCH;
constexpr size_t UGS = (size_t)UROWS * 1024;
constexpr float EPS = 1e-6f;

struct Params {
  const float *x, *c, *ctx, *c_ctx, *norm_g, *w_ada, *b_ada, *w_in, *conv_dw, *conv_db, *conv_ln_g, *conv_ln_b,
      *a_re, *a_im, *log_dt, *b_re, *b_im, *c_re, *c_im, *ssm_d, *glu_w, *glu_b, *w_out, *final_g;
  float* out;
  float *mod, *rowsq, *lam64, *S;
  int* ctr;
  unsigned* bar;
  u16 *WinT, *GluT, *WoutT, *BpowT, *CpowT, *Kc, *Hb, *Hc, *V, *SGC, *SGS, *Ug, *Hp;
};

__device__ __forceinline__ u16 f2bf(float f) {
  unsigned u = __float_as_uint(f);
  u += 0x7fffu + ((u >> 16) & 1u);
  return (u16)(u >> 16);
}
__device__ __forceinline__ float bf2f(u16 h) { return __uint_as_float(((unsigned)h) << 16); }
__device__ __forceinline__ float bflo(unsigned u) { return __uint_as_float(u << 16); }
__device__ __forceinline__ float bfhi(unsigned u) { return __uint_as_float(u & 0xffff0000u); }
__device__ __forceinline__ unsigned pack2(float a, float b) { unsigned r; asm("v_cvt_pk_bf16_f32 %0, %1, %2" : "=v"(r) : "v"(a), "v"(b)); return r; }
__device__ __forceinline__ float sigmoidf_(float x) { return __builtin_amdgcn_rcpf(1.f + __builtin_amdgcn_exp2f(-1.4426950408889634f * x)); }
__device__ __forceinline__ float siluf_(float x) { return x * sigmoidf_(x); }
__device__ __forceinline__ float gelu_tanh(float x) {
  float z = 0.7978845608028654f * (x + 0.044715f * x * x * x);
  return x * __builtin_amdgcn_rcpf(1.f + __builtin_amdgcn_exp2f(-2.885390081777927f * z));
}
__device__ __forceinline__ float wave_sum(float v) {
#pragma unroll
  for (int o = 32; o >= 1; o >>= 1) v += __shfl_xor(v, o);
  return v;
}

template <int CTRL>
__device__ __forceinline__ float dpp_add(float v) {
  return v + __int_as_float(__builtin_amdgcn_update_dpp(0, __float_as_int(v), CTRL, 0xf, 0xf, true));
}
__device__ __forceinline__ float wave_sum_fast(float v) {
  v = dpp_add<0xB1>(v); v = dpp_add<0x4E>(v); v = dpp_add<0x141>(v); v = dpp_add<0x140>(v);
  const int iv = __float_as_int(v);
  return (__int_as_float(__builtin_amdgcn_readlane(iv, 0)) + __int_as_float(__builtin_amdgcn_readlane(iv, 16))) +
         (__int_as_float(__builtin_amdgcn_readlane(iv, 32)) + __int_as_float(__builtin_amdgcn_readlane(iv, 48)));
}

__device__ __forceinline__ void lam_pow(float a_re, float a_im, double dt, int e, double& pr, double& pi) {
  double ang = (double)e * dt * (double)a_im;
  ang -= 6.283185307179586476925 * rint(ang * 0.15915494309189533577);
  float mag = expf((float)((double)e * dt * (double)a_re));
  float s, c;
  sincosf((float)ang, &s, &c);
  pr = (double)(mag * c); pi = (double)(mag * s);
}
__device__ __forceinline__ void zoh_coef(float a_re, float a_im, double dt, double& cr, double& ci) {
  double ang = dt * (double)a_im;
  double mag = exp(dt * (double)a_re);
  double s, c;
  sincos(ang, &s, &c);
  double nr = mag * c - 1.0, ni = mag * s;
  double dr = (double)a_re, di = (double)a_im;
  double den = dr * dr + di * di;
  cr = (nr * dr + ni * di) / den;
  ci = (ni * dr - nr * di) / den;
}
__device__ __forceinline__ double dt_of(const float* log_dt, int dg) { return (double)expf(log_dt[dg]); }
__device__ __forceinline__ void lam_powf(float a_re, float a_im, double dt, int e, float& pr, float& pi) {
  double ang = (double)e * dt * (double)a_im;
  ang -= 6.283185307179586476925 * rint(ang * 0.15915494309189533577);
  const float mag = expf((float)e * (float)dt * a_re);
  float sn, cs;
  sincosf((float)ang, &sn, &cs);
  pr = mag * cs; pi = mag * sn;
}

#define LAS __attribute__((address_space(3)))
constexpr int HTB = 128 * 64 * 2;
constexpr int STAGE_BYTES = 8 * HTB;
__device__ __forceinline__ int lds_byte(int r, int c) {
  int st = (r >> 4) * 2 + (c >> 5), rr = r & 15, cc = c & 31, ob = rr * 64 + cc * 2;
  return st * 1024 + (ob ^ (((ob >> 9) & 1) << 5));
}
__device__ __forceinline__ void stage_rc(int b, int& R, int& C) {
  int st = b / 1024, sb = b % 1024, swz = sb ^ (((sb >> 9) & 1) << 5);
  R = (st >> 1) * 16 + swz / 64;
  C = (st & 1) * 32 + (swz % 64) / 2;
}
__device__ __forceinline__ int perm32(int rho) { const int n = rho >> 4, i = rho & 15; return 8 * (i >> 2) + 4 * n + (i & 3); }
struct Unit { int pm, pn, aux; };

template <int WGM = 8>
__device__ __forceinline__ void static_order(int L, int nM, int nN, int& pm, int& pn) {
  const int nwg = nM * nN;
  int wgid = L;
  { const int q = nwg / 8, r = nwg % 8, xcd = wgid % 8, off = wgid / 8; wgid = (xcd < r ? xcd * (q + 1) : r * (q + 1) + (xcd - r) * q) + off; }
  const int nig = WGM * nN, gid = wgid / nig, fm = gid * WGM, gsz = (nM - fm) < WGM ? (nM - fm) : WGM;
  pm = fm + ((wgid % nig) % gsz); pn = (wgid % nig) / gsz;
}

template <class Prob>
__device__ __forceinline__ void gemm_phase(LAS unsigned char* lds, const Prob& P) {
  int tid_ = threadIdx.x;
  asm volatile("" : "+v"(tid_));
  const int tid = tid_, wid = __builtin_amdgcn_readfirstlane(tid >> 6), lane = tid & 63, wr = wid >> 2, wc = wid & 3, fr = lane & 15, fq = lane >> 4;
  constexpr int nt = Prob::NT;
  unsigned voA0[2], voA1[2], voB0[2], voB1[2];
#pragma unroll
  for (int i = 0; i < 2; ++i) {
    int R, C; stage_rc(tid * 16 + i * 8192, R, C);
    const int Rb = Prob::PERM ? ((R & ~31) + perm32(R & 31)) : R;
    voA0[i] = P.avoff(0, R, C); voA1[i] = Prob::A2 ? P.avoff(1, R, C) : 0u;
    voB0[i] = P.bvoff(0, Rb, C); voB1[i] = Prob::B2 ? P.bvoff(1, Rb, C) : 0u;
  }
  const unsigned ldsw = (unsigned)wid * 1024u;
  const int aoff = lds_byte(wr * 64 + fr, fq * 8), boff = lds_byte(wc * 32 + fr, fq * 8);
#define G_SA(b, h) (((b) * 2 + (h)) * HTB)
#define G_SB(b, h) ((4 + (b) * 2 + (h)) * HTB)
#define G_STAGE_A(bufoff, u, h, kt) do { const char* _g = P.abase(u, h, kt); const bool _s = Prob::A2 && P.asel(kt); \
    _Pragma("unroll") for (int _i = 0; _i < 2; ++_i) __builtin_amdgcn_global_load_lds((const unsigned*)(_g + (_s ? voA1[_i] : voA0[_i])), (LAS unsigned*)(lds + (bufoff) + ldsw + _i * 8192), 16, 0, 0); } while (0)
#define G_STAGE_B(bufoff, u, h, kt) do { const char* _g = P.bbase(u, h, kt); const bool _s = Prob::B2 && P.bsel(kt); \
    _Pragma("unroll") for (int _i = 0; _i < 2; ++_i) __builtin_amdgcn_global_load_lds((const unsigned*)(_g + (_s ? voB1[_i] : voB0[_i])), (LAS unsigned*)(lds + (bufoff) + ldsw + _i * 8192), 16, 0, 0); } while (0)
#define G_LDA(dst, b, h) do { _Pragma("unroll") for (int m = 0; m < 4; ++m) _Pragma("unroll") for (int k = 0; k < 2; ++k) dst[m][k] = *(const LAS bf16x8*)(lds + G_SA(b, h) + aoff + m * 2048 + k * 1024); } while (0)
#define G_LDB(dst, b, h) do { _Pragma("unroll") for (int n = 0; n < 2; ++n) _Pragma("unroll") for (int k = 0; k < 2; ++k) dst[n][k] = *(const LAS bf16x8*)(lds + G_SB(b, h) + boff + n * 2048 + k * 1024); } while (0)
#define G_MMA(ai, bj, At, Bt) do { __builtin_amdgcn_s_setprio(1); _Pragma("unroll") for (int m = 0; m < 4; ++m) _Pragma("unroll") for (int n = 0; n < 2; ++n) _Pragma("unroll") for (int k = 0; k < 2; ++k) \
    acc[ai][bj][m][n] = __builtin_amdgcn_mfma_f32_16x16x32_bf16(Bt[n][k], At[m][k], acc[ai][bj][m][n], 0, 0, 0); __builtin_amdgcn_s_setprio(0); } while (0)
#define G_WAIT_V(n) asm volatile("s_waitcnt vmcnt(" #n ")" ::: "memory")
#define G_WAIT_L(n) asm volatile("s_waitcnt lgkmcnt(" #n ")" ::: "memory")
#define G_BAR __builtin_amdgcn_s_barrier()
#define G_SCHED __builtin_amdgcn_sched_barrier(0)
  Unit cur, nxt; int ui = 0;
  if (!P.next(0, cur)) return;
  f32x4 acc[2][2][4][2];
#pragma unroll
  for (int a = 0; a < 2; ++a)
#pragma unroll
    for (int b = 0; b < 2; ++b)
#pragma unroll
      for (int m = 0; m < 4; ++m)
#pragma unroll
        for (int n = 0; n < 2; ++n) acc[a][b][m][n] = (f32x4){0.f, 0.f, 0.f, 0.f};
  bf16x8 At[4][2], B0[2][2], B1[2][2];
  G_STAGE_B(G_SB(0, 0), cur, 0, 0); G_STAGE_A(G_SA(0, 0), cur, 0, 0); G_STAGE_B(G_SB(0, 1), cur, 1, 0); G_STAGE_A(G_SA(0, 1), cur, 1, 0);
  if (wr == 1) G_BAR;
  G_WAIT_V(4); G_BAR;
  G_STAGE_B(G_SB(1, 0), cur, 0, 1); G_STAGE_A(G_SA(1, 0), cur, 0, 1); G_STAGE_B(G_SB(1, 1), cur, 1, 1);
  G_WAIT_V(6); G_BAR;
  for (;;) {
    const bool has_next = P.next(ui + 1, nxt);
    const Unit nu = has_next ? nxt : cur;
    for (int t = 0; t < nt; t += 2) {
      const bool last = (t == nt - 2);
      const Unit u2 = last ? nu : cur;
      const int k2 = last ? 0 : t + 2, k3 = k2 + 1;
      G_LDB(B0, 0, 0); G_SCHED; G_LDA(At, 0, 0); G_STAGE_A(G_SA(1, 1), cur, 1, t + 1);
      G_WAIT_L(8); G_BAR; G_WAIT_L(0); G_MMA(0, 0, At, B0); G_BAR; G_SCHED;
      G_LDB(B1, 0, 1); G_STAGE_B(G_SB(0, 0), u2, 0, k2);
      G_BAR; G_WAIT_L(0); G_MMA(0, 1, At, B1); G_BAR;
      G_LDA(At, 0, 1); G_STAGE_A(G_SA(0, 0), u2, 0, k2);
      G_BAR; G_WAIT_L(0); G_MMA(1, 0, At, B0); G_BAR; G_SCHED;
      G_STAGE_B(G_SB(0, 1), u2, 1, k2);
      G_WAIT_V(6); G_BAR; G_MMA(1, 1, At, B1); G_BAR;
      G_LDB(B0, 1, 0); G_SCHED; G_LDA(At, 1, 0); G_STAGE_A(G_SA(0, 1), u2, 1, k2);
      G_WAIT_L(8); G_BAR; G_WAIT_L(0); G_MMA(0, 0, At, B0); G_BAR; G_SCHED;
      G_LDB(B1, 1, 1); G_STAGE_B(G_SB(1, 0), u2, 0, k3);
      G_BAR; G_WAIT_L(0); G_MMA(0, 1, At, B1); G_BAR;
      G_LDA(At, 1, 1); G_STAGE_A(G_SA(1, 0), u2, 0, k3);
      G_BAR; G_WAIT_L(0); G_MMA(1, 0, At, B0); G_BAR; G_SCHED;
      G_STAGE_B(G_SB(1, 1), u2, 1, k3);
      G_WAIT_V(6); G_BAR; G_MMA(1, 1, At, B1); G_BAR;
    }
    P.epi(acc, cur, wr, wc, fr, fq);
    if (!has_next) break;
#pragma unroll
    for (int a = 0; a < 2; ++a)
#pragma unroll
      for (int b = 0; b < 2; ++b)
#pragma unroll
        for (int m = 0; m < 4; ++m)
#pragma unroll
          for (int n = 0; n < 2; ++n) acc[a][b][m][n] = (f32x4){0.f, 0.f, 0.f, 0.f};
    cur = nxt; ++ui;
  }
  G_WAIT_V(0);
  if (wr == 0) G_BAR;
  G_BAR;
}


#define XB_TMO      128
#define XB_XCNT(j)  (256  + 64 * (j))
#define XB_XSUB(j)  (1280 + 64 * (j))
#define XB_XGEN(j)  (2304 + 64 * (j))
#define XB_TOP      3328
#define XB_TOPGEN   3392
#define XCD_BAR_WORDS 3456
#define XB_SPIN_CAP (1u << 18)
__device__ __forceinline__ unsigned xb_ld(unsigned* p)              { return __hip_atomic_load(p, __ATOMIC_RELAXED, __HIP_MEMORY_SCOPE_AGENT); }
__device__ __forceinline__ unsigned xb_add(unsigned* p, unsigned v) { return __hip_atomic_fetch_add(p, v, __ATOMIC_RELAXED, __HIP_MEMORY_SCOPE_AGENT); }
__device__ __forceinline__ unsigned xb_xcc_id() { return (unsigned)__builtin_amdgcn_s_getreg((3 << 11) | 20) & 0xFu; }
#define XB_SPIN(cond, bar) do { unsigned _sp = 0; while (cond) { __builtin_amdgcn_s_sleep(1); \
    if ((++_sp & 255u) == 0u) { if (xb_ld(&(bar)[XB_TMO])) break; if (_sp > XB_SPIN_CAP) { atomicAdd(&(bar)[XB_TMO], 1u); break; } } } } while (0)
struct XcdBarrier { unsigned* bar; unsigned x; volatile LAS unsigned* st; };
__device__ __forceinline__ XcdBarrier xcd_barrier_post(unsigned* bar, volatile LAS unsigned* st) {
  XcdBarrier b; b.bar = bar; b.x = xb_xcc_id(); b.st = st;
  if (threadIdx.x == 0) (void)xb_add(&bar[XB_XCNT(b.x)], 1u);
  return b;
}
__device__ __forceinline__ void xcd_barrier_complete(unsigned* bar, unsigned x, unsigned& nloc, unsigned& nx) {
  const unsigned G = gridDim.x * gridDim.y * gridDim.z;
  unsigned sum, cnt, mine, sp = 0u;
  for (;;) {
    sum = 0u; cnt = 0u; mine = 0u;
#pragma unroll
    for (unsigned j = 0; j < 16; ++j) { const unsigned c = xb_ld(&bar[XB_XCNT(j)]); sum += c; cnt += (c > 0u) ? 1u : 0u; mine = (j == x) ? c : mine; }
    if (sum == G) break;
    __builtin_amdgcn_s_sleep(1);
    if ((++sp & 255u) == 0u) { if (xb_ld(&bar[XB_TMO])) break; if (sp > XB_SPIN_CAP) { atomicAdd(&bar[XB_TMO], 1u); break; } }
  }
  nloc = mine > 0u ? mine : 1u; nx = cnt > 0u ? cnt : 1u;
}
__device__ __forceinline__ void xcd_barrier(const XcdBarrier& b) {
  asm volatile("s_waitcnt vmcnt(0)" ::: "memory");
  __syncthreads();
  if (threadIdx.x == 0) {
    unsigned* bar = b.bar;
    __builtin_amdgcn_s_waitcnt(0);
    unsigned nloc = b.st[0], nx = b.st[1];
    if (nloc == 0u) { xcd_barrier_complete(bar, b.x, nloc, nx); b.st[0] = nloc; b.st[1] = nx; }
    const unsigned old = xb_add(&bar[XB_XSUB(b.x)], 1u);
    const unsigned gen = old / nloc;
    if (old + 1u == (gen + 1u) * nloc) {
      __builtin_amdgcn_fence(__ATOMIC_RELEASE, "agent");
      asm volatile("s_waitcnt vmcnt(0)" ::: "memory");
      const unsigned og = xb_add(&bar[XB_TOP], 1u);
      const unsigned tg = og / nx;
      if (og + 1u == (tg + 1u) * nx) xb_add(&bar[XB_TOPGEN], 1u);
      else XB_SPIN(xb_ld(&bar[XB_TOPGEN]) == tg, bar);
      __builtin_amdgcn_fence(__ATOMIC_ACQUIRE, "agent");
      xb_add(&bar[XB_XGEN(b.x)], 1u);
      asm volatile("s_waitcnt vmcnt(0)" ::: "memory");
    } else {
      XB_SPIN(xb_ld(&bar[XB_XGEN(b.x)]) == gen, bar);
      __builtin_amdgcn_fence(__ATOMIC_ACQUIRE, "agent");
      asm volatile("s_waitcnt vmcnt(0)" ::: "memory");
    }
  }
  __syncthreads();
}

__device__ __forceinline__ uint4 pack8(const f32x4& a, const f32x4& b) {
  return make_uint4(pack2(a[0], a[1]), pack2(a[2], a[3]), pack2(b[0], b[1]), pack2(b[2], b[3]));
}
__device__ void p0_mod(const Params& p, int item, unsigned char* smem) {
  float* s = (float*)smem;
  float* red = s + 9 * 1024;
  int tid_o = threadIdx.x; asm volatile("" : "+v"(tid_o)); const int tid = tid_o & 255;
  for (int i = tid; i < 9 * 1024; i += 256) {
    int r = i >> 10, k = i & 1023;
    float v = (r < 8) ? p.c[r * 1024 + k] : p.c_ctx[k];
    s[i] = siluf_(v);
  }
  __syncthreads();
  const int ks = tid >> 4, cl = tid & 15, j = item * 16 + cl;
  float acc[9];
#pragma unroll
  for (int r = 0; r < 9; ++r) acc[r] = 0.f;
  for (int k = ks * 64; k < ks * 64 + 64; ++k) {
    float w = p.w_ada[(size_t)k * 3072 + j];
#pragma unroll
    for (int r = 0; r < 9; ++r) acc[r] += s[r * 1024 + k] * w;
  }
#pragma unroll
  for (int r = 0; r < 9; ++r) red[(ks * 16 + cl) * 9 + r] = acc[r];
  __syncthreads();
  if (tid < 144) {
    int r = tid >> 4, c2 = tid & 15, jj = item * 16 + c2;
    float a = p.b_ada[jj];
    for (int q = 0; q < 16; ++q) a += red[(q * 16 + c2) * 9 + r];
    p.mod[r * 3072 + jj] = a;
  }
  __syncthreads();
}

template <bool PERM>
__device__ void p0_transpose(const float* src, int N, u16* dst, int Kd, int kt, int nt, unsigned char* smem) {
  float* t = (float*)smem;
  int tid_o = threadIdx.x; asm volatile("" : "+v"(tid_o)); const int tid = tid_o & 255;
#pragma unroll
  for (int i = 0; i < 16; ++i) {
    int e = i * 256 + tid, kr = e >> 6, nc = e & 63;
    t[kr * 65 + nc] = src[(size_t)(kt * 64 + kr) * N + nt * 64 + nc];
  }
  __syncthreads();
  {
    int nl = tid >> 2, kq = tid & 3;
    int n = nt * 64 + nl, np = n;
    if (PERM) {
      if (n < 2048) {
        int sec = n >> 10, ch = n & 1023;
        np = (ch >> 7) * 256 + sec * 128 + (ch & 127);
      }
    }
    unsigned w[8];
#pragma unroll
    for (int q = 0; q < 8; ++q) w[q] = pack2(t[(kq * 16 + q * 2) * 65 + nl], t[(kq * 16 + q * 2 + 1) * 65 + nl]);
    uint4* d = (uint4*)(dst + (size_t)np * Kd + kt * 64 + kq * 16);
    d[0] = make_uint4(w[0], w[1], w[2], w[3]);
    d[1] = make_uint4(w[4], w[5], w[6], w[7]);
  }
  __syncthreads();
}

__device__ void p0_bpow(const Params& p, int item) {
  int tid_o = threadIdx.x; asm volatile("" : "+v"(tid_o)); const int tid = tid_o & 255;
  int dg = item >> 3, nb = item & 7;
  int n = nb * 16 + (tid >> 4), ri = n >> 6, pp = n & 63;
  int d = dg >> 6;
  int s0 = (tid & 15) * 4;
  double dt = dt_of(p.log_dt, dg);
  float are = p.a_re[dg * 64 + pp], aim = p.a_im[dg * 64 + pp];
  double cr, ci;
  zoh_coef(are, aim, dt, cr, ci);
  const float* br = p.b_re + ((size_t)dg * 64 + pp) * 16;
  const float* bi = p.b_im + ((size_t)dg * 64 + pp) * 16;
  u16* dst = p.BpowT + ((size_t)dg * 128 + n) * 1024 + s0 * 16;
  const float cfr = (float)cr, cfi = (float)ci;
  float brv[16], biv[16];
#pragma unroll
  for (int h = 0; h < 16; ++h) { brv[h] = br[h]; biv[h] = bi[h]; }
  for (int q = 0; q < 4; ++q) {
    int s = s0 + q;
    int e = (d == 0) ? (63 - s) : s;
    float lr, li;
    lam_powf(are, aim, dt, e, lr, li);
    const float wr_ = lr * cfr - li * cfi, wi_ = lr * cfi + li * cfr;
    unsigned w[8];
#pragma unroll
    for (int h2 = 0; h2 < 8; ++h2) {
      float v0, v1;
      if (ri == 0) { v0 = wr_ * brv[h2 * 2] - wi_ * biv[h2 * 2]; v1 = wr_ * brv[h2 * 2 + 1] - wi_ * biv[h2 * 2 + 1]; }
      else         { v0 = wr_ * biv[h2 * 2] + wi_ * brv[h2 * 2]; v1 = wr_ * biv[h2 * 2 + 1] + wi_ * brv[h2 * 2 + 1]; }
      w[h2] = pack2(v0, v1);
    }
    uint4* dd = (uint4*)(dst + q * 16);
    dd[0] = make_uint4(w[0], w[1], w[2], w[3]);
    dd[1] = make_uint4(w[4], w[5], w[6], w[7]);
  }
}

__device__ void p0_cpow(const Params& p, int item) {
  int tid_o = threadIdx.x; asm volatile("" : "+v"(tid_o)); const int tid = tid_o & 255;
  int g = item >> 6, t = item & 63;
  int d = tid >> 7, ri = (tid >> 6) & 1, pp = tid & 63;
  int dg = d * 64 + g;
  double dt = dt_of(p.log_dt, dg);
  float are = p.a_re[dg * 64 + pp], aim = p.a_im[dg * 64 + pp];
  int e = (d == 0) ? (t + 1) : (64 - t);
  float lr, li;
  lam_powf(are, aim, dt, e, lr, li);
  float crv[16], civ[16];
#pragma unroll
  for (int hp = 0; hp < 16; ++hp) { crv[hp] = p.c_re[((size_t)dg * 16 + hp) * 64 + pp]; civ[hp] = p.c_im[((size_t)dg * 16 + hp) * 64 + pp]; }
#pragma unroll
  for (int hp = 0; hp < 16; ++hp) {
    const float wr_ = crv[hp] * lr - civ[hp] * li, wi_ = crv[hp] * li + civ[hp] * lr;
    p.CpowT[((size_t)g * 1024 + t * 16 + hp) * 256 + tid] = f2bf((ri == 0) ? wr_ : -wi_);
  }
}

__device__ void p0_kc(const Params& p, int item, unsigned char* smem) {
  float2* Cs = (float2*)smem;
  float2* Bs = Cs + 2 * 16 * 65;
  float4* Ws = (float4*)(Bs + 2 * 64 * 16);
  int tid_o = threadIdx.x; asm volatile("" : "+v"(tid_o)); const int tid = tid_o & 255;
  const int g = item >> 3, blk = item & 7;
  const int dm = (blk <= 3) ? 1 : 0;
  __syncthreads();
  for (int i = tid; i < 2 * 1024; i += 256) {
    int d = i >> 10, j = i & 1023, dg = d * 64 + g;
    int hp = j >> 6, pp = j & 63;
    Cs[(d * 16 + hp) * 65 + pp] = make_float2(p.c_re[(size_t)dg * 1024 + j], p.c_im[(size_t)dg * 1024 + j]);
  }
  if (tid < 128) {
    int d = tid >> 6, pp = tid & 63, dg = d * 64 + g;
    double dt = dt_of(p.log_dt, dg);
    float are = p.a_re[dg * 64 + pp], aim = p.a_im[dg * 64 + pp];
    double cr, ci;
    zoh_coef(are, aim, dt, cr, ci);
    const float cfr = (float)cr, cfi = (float)ci;
    const float* br = p.b_re + ((size_t)dg * 64 + pp) * 16;
    const float* bi = p.b_im + ((size_t)dg * 64 + pp) * 16;
    for (int h = 0; h < 16; ++h) {
      const float b_r = br[h], b_i = bi[h];
      Bs[(d * 64 + pp) * 16 + h] = make_float2(cfr * b_r - cfi * b_i, cfr * b_i + cfi * b_r);
    }
  }
  {
    const int dg = dm * 64 + g;
    const double dt = dt_of(p.log_dt, dg);
    for (int i = tid; i < 1024; i += 256) {
      int sl = i >> 6, pp = i & 63, ti = blk * 16 + sl, tau = ti - 63;
      int e = tau < 0 ? -tau : tau;
      float lr, li;
      lam_powf(p.a_re[dg * 64 + pp], p.a_im[dg * 64 + pp], dt, e, lr, li);
      float2* wp = (float2*)(Ws + pp * 8 + (sl >> 1)) + (sl & 1);
      *wp = make_float2(lr, li);
    }
  }
  __syncthreads();
  const int hp = tid >> 4, h = tid & 15;
  float acc[16];
#pragma unroll
  for (int sl = 0; sl < 16; ++sl) acc[sl] = 0.f;
  {
    const float2* cr = Cs + (dm * 16 + hp) * 65;
    const float2* bb = Bs + dm * 1024 + h;
#pragma unroll 1
    for (int pp = 0; pp < 64; ++pp) {
      const float2 c = cr[pp], b = bb[pp * 16];
      const float zr = c.x * b.x - c.y * b.y, zi = c.x * b.y + c.y * b.x;
#pragma unroll
      for (int j = 0; j < 8; ++j) {
        const float4 w = Ws[pp * 8 + j];
        acc[2 * j] += w.x * zr - w.y * zi;
        acc[2 * j + 1] += w.z * zr - w.w * zi;
      }
    }
  }
  if (blk == 3) {
    const float2* cr = Cs + hp * 65;
    const float2* bb = Bs + h;
    float e0 = 0.f;
#pragma unroll 4
    for (int pp = 0; pp < 64; ++pp) { const float2 c = cr[pp], b = bb[pp * 16]; e0 += c.x * b.x - c.y * b.y; }
    acc[15] += e0 + ((hp == h) ? p.ssm_d[g * 16 + h] : 0.f);
  }
#pragma unroll
  for (int sl = 0; sl < 16; ++sl) {
    const int ti = blk * 16 + sl;
    if (ti < 127) p.Kc[((size_t)g * 128 + ti) * 256 + tid] = f2bf(acc[sl]);
  }
  __syncthreads();
}

__device__ void p0_misc(const Params& p, int item) {
  int tid_o = threadIdx.x; asm volatile("" : "+v"(tid_o)); const int tid = tid_o & 255;
  if (item < 32) {
    int idx = item * 256 + tid;
    int dg = idx >> 6;
    double dt = dt_of(p.log_dt, dg);
    double lr, li;
    lam_pow(p.a_re[idx], p.a_im[idx], dt, 64, lr, li);
    p.lam64[idx * 2] = (float)lr;
    p.lam64[idx * 2 + 1] = (float)li;
  } else if (item < 64) {
    int idx = (item - 32) * 1024 + tid * 4;
    *(float4*)(p.rowsq + idx) = make_float4(0.f, 0.f, 0.f, 0.f);
  } else if (item == 64) {
#pragma unroll
    for (int i = 0; i < 4; ++i) *(int4*)(p.ctr + i * 1024 + tid * 4) = make_int4(0, 0, 0, 0);
  }
}


constexpr int P0_MOD = 192, P0_TIN = 16 * 80, P0_TGLU = 16 * 16, P0_TOUT = 32 * 16, P0_BPOW = 1024, P0_CPOW = 4096,
              P0_KC = 64 * 8, P0_MISC = 66;
__device__ void phase0(const Params& p, unsigned char* smem0, const int mask = 0xff) {
  constexpr int o1 = P0_MOD, o2 = o1 + P0_KC, o3 = o2 + P0_TIN, o4 = o3 + P0_TGLU, o5 = o4 + P0_TOUT, o6 = o5 + P0_BPOW,
                o7 = o6 + P0_CPOW, o8 = o7 + P0_MISC;
  const int hb = threadIdx.x >> 8;
  unsigned char* smem = smem0 + hb * 65536;
  for (int it2 = blockIdx.x; it2 < o8 / 2; it2 += gridDim.x) {
    const int it = it2 * 2 + hb;
    if (it < o1) { if (mask & 1) p0_mod(p, it, smem); }
    else if (it < o2) { if (mask & 2) p0_kc(p, it - o1, smem); }
    else if (it < o3) { if (mask & 4) { int i = it - o2; p0_transpose<true>(p.w_in, 5120, p.WinT, 1024, i / 80, i % 80, smem); } }
    else if (it < o4) { if (mask & 4) { int i = it - o3; p0_transpose<false>(p.glu_w, 1024, p.GluT, 1024, i / 16, i % 16, smem); } }
    else if (it < o5) { if (mask & 4) { int i = it - o4; p0_transpose<false>(p.w_out, 1024, p.WoutT, 2048, i / 16, i % 16, smem); } }
    else if (it < o6) { if (mask & 8) p0_bpow(p, it - o5); }
    else if (it < o7) { if (mask & 16) p0_cpow(p, it - o6); }
    else { if (mask & 32) p0_misc(p, it - o7); }
  }
}

template <int MODE>
struct ProbIn {
  static constexpr int NT = 16; static constexpr bool PERM = true, A2 = false, B2 = false;
  Params p; int G, c;
  __device__ __forceinline__ bool next(int i, Unit& u) const {
    if (MODE == 1) { if (i > 0 || c >= 32) return false; u.pm = c >> 2; u.pn = 12 + (c & 3); u.aux = 1; return true; }
    if (MODE == 2) { const int j = i * G + c; if (j >= 32) return false; u.pm = j >> 2; u.pn = 12 + (j & 3); u.aux = 1; return true; }
    const int L = i * G + c;
    if (L < 2560) { static_order<4>(L, 128, 20, u.pm, u.pn); u.aux = 0; return true; }
    return false;
  }
  __device__ __forceinline__ unsigned avoff(int, int R, int C) const { return (unsigned)(R * 1024 + C) * 2u; }
  __device__ __forceinline__ unsigned bvoff(int, int R, int C) const { return (unsigned)(R * 1024 + C) * 2u; }
  __device__ __forceinline__ bool asel(int) const { return false; }
  __device__ __forceinline__ bool bsel(int) const { return false; }
  __device__ __forceinline__ const char* abase(const Unit& u, int h, int kt) const {
    return (const char*)p.Hb + ((size_t)((u.pm + u.aux * 128) * 256 + h * 128) * 1024 + kt * 64) * 2;
  }
  __device__ __forceinline__ const char* bbase(const Unit& u, int h, int kt) const {
    return (const char*)p.WinT + ((size_t)(u.pn * 256 + h * 128) * 1024 + kt * 64) * 2;
  }
  __device__ __forceinline__ void epi(const f32x4 (&acc)[2][2][4][2], const Unit& u, int wr, int wc, int fr, int fq) const {
    const int row0 = u.pm * 256 + wr * 64 + fr;
    if (u.pn < 8) {
      const int ch = u.pn * 128 + wc * 32 + fq * 8;
#pragma unroll
      for (int ai = 0; ai < 2; ++ai)
#pragma unroll
        for (int m = 0; m < 4; ++m) {
          const int r = row0 + ai * 128 + m * 16;
          f32x4 v0, v1;
#pragma unroll
          for (int j = 0; j < 4; ++j) {
            v0[j] = acc[ai][0][m][0][j] * sigmoidf_(acc[ai][1][m][0][j]);
            v1[j] = acc[ai][0][m][1][j] * sigmoidf_(acc[ai][1][m][1][j]);
          }
          *(uint4*)(p.V + (size_t)r * 1024 + ch) = pack8(v0, v1);
        }
    } else if (u.pn < 12 || u.pn >= 16) {
      u16* dstb = p.SGC + ((u.pn < 12) ? (size_t)0 : (size_t)NTOK * 1024);
      const int cb = ((u.pn < 12) ? (u.pn - 8) : (u.pn - 16)) * 256 + wc * 32 + fq * 8;
#pragma unroll
      for (int ai = 0; ai < 2; ++ai)
#pragma unroll
        for (int m = 0; m < 4; ++m) {
          const int r = row0 + ai * 128 + m * 16;
#pragma unroll
          for (int bj = 0; bj < 2; ++bj) {
            f32x4 v0, v1;
#pragma unroll
            for (int j = 0; j < 4; ++j) { v0[j] = siluf_(acc[ai][bj][m][0][j]); v1[j] = siluf_(acc[ai][bj][m][1][j]); }
            *(uint4*)(dstb + (size_t)r * 1024 + cb + bj * 128) = pack8(v0, v1);
          }
        }
    } else {
#pragma unroll
      for (int ai = 0; ai < 2; ++ai)
#pragma unroll
        for (int m = 0; m < 4; ++m) {
          const int r = row0 + ai * 128 + m * 16;
          size_t tokrow;
          if (!u.aux) { int b = r >> 12, l = r & 4095; tokrow = (size_t)b * 4352 + 256 + l; }
          else { int b = r >> 8, l = r & 255; tokrow = (size_t)b * 4352 + l; }
#pragma unroll
          for (int bj = 0; bj < 2; ++bj) {
            const int g = (u.pn - 12) * 16 + bj * 8 + wc * 2 + (fq >> 1);
            *(uint4*)(p.Ug + (size_t)g * UGS + tokrow * 16 + (fq & 1) * 8) = pack8(acc[ai][bj][m][0], acc[ai][bj][m][1]);
          }
        }
    }
  }
};

__device__ __forceinline__ const float* p1_src(const Params& p, int r) {
  return (r < NTOK) ? (p.x + (size_t)r * 1024) : (p.ctx + (size_t)(r - NTOK) * 1024);
}
template <int NQ>
__device__ __forceinline__ void p1_rows(const Params& p, const float4 (&v)[NQ][4], int r0, int lane) {
#pragma unroll
  for (int q = 0; q < NQ; ++q) {
    const int r = r0 + q;
    u16* dst = p.Hb + (size_t)r * 1024;
    const int mrow = (r < NTOK) ? (r >> 12) : 8;
    float ss = 0.f;
#pragma unroll
    for (int i = 0; i < 4; ++i) ss += v[q][i].x * v[q][i].x + v[q][i].y * v[q][i].y + v[q][i].z * v[q][i].z + v[q][i].w * v[q][i].w;
    ss = wave_sum(ss);
    const float rstd = rsqrtf(ss * (1.f / 1024.f) + EPS);
    const float* shift = p.mod + mrow * 3072;
    const float* scale = shift + 1024;
#pragma unroll
    for (int i = 0; i < 4; ++i) {
      const int idx = i * 256 + lane * 4;
      const float4 g = *(const float4*)(p.norm_g + idx);
      const float4 sc = *(const float4*)(scale + idx);
      const float4 sh = *(const float4*)(shift + idx);
      const float h0 = v[q][i].x * rstd * g.x * (1.f + sc.x) + sh.x;
      const float h1 = v[q][i].y * rstd * g.y * (1.f + sc.y) + sh.y;
      const float h2 = v[q][i].z * rstd * g.z * (1.f + sc.z) + sh.z;
      const float h3 = v[q][i].w * rstd * g.w * (1.f + sc.w) + sh.w;
      *(uint2*)(dst + idx) = make_uint2(pack2(h0, h1), pack2(h2, h3));
    }
  }
}
__device__ __forceinline__ int p1_item(int c, int k) {
  if (c < 32) return -1;
  const int it = (c - 32) + k * 224;
  return (it < NTOK / 16) ? it : -1;
}
__device__ void phase1(const Params& p, unsigned char* smem) {
  const int wid = threadIdx.x >> 6, lane = threadIdx.x & 63;
  const int c = blockIdx.x, G = gridDim.x;
  if (G == 256 && c < 32) {
    const int rbase = NTOK + (c >> 2) * 256 + wid * 32;
    {
      float4 v[4][4], vn[4][4];
#pragma unroll
      for (int q = 0; q < 4; ++q) {
        const float* src = p1_src(p, rbase + q);
#pragma unroll
        for (int i = 0; i < 4; ++i) v[q][i] = *(const float4*)(src + i * 256 + lane * 4);
      }
#pragma unroll 1
      for (int j = 0; j < 8; ++j) {
        if (j < 7) {
#pragma unroll
          for (int q = 0; q < 4; ++q) {
            const float* src = p1_src(p, rbase + (j + 1) * 4 + q);
#pragma unroll
            for (int i = 0; i < 4; ++i) vn[q][i] = *(const float4*)(src + i * 256 + lane * 4);
          }
        }
        p1_rows<4>(p, v, rbase + j * 4, lane);
#pragma unroll
        for (int q = 0; q < 4; ++q)
#pragma unroll
          for (int i = 0; i < 4; ++i) v[q][i] = vn[q][i];
      }
    }
    asm volatile("s_waitcnt vmcnt(0)" ::: "memory");
    __threadfence();
    __syncthreads();
    ProbIn<1> P{p, G, c};
    gemm_phase((LAS unsigned char*)smem, P);
  }
  if (G == 256) {
    float4 v[2][4], vn[2][4];
    int k = 0, it = p1_item(c, 0);
    if (it >= 0) {
#pragma unroll
      for (int q = 0; q < 2; ++q) {
        const float* src = p.x + (size_t)(it * 16 + wid * 2 + q) * 1024;
#pragma unroll
        for (int i = 0; i < 4; ++i) v[q][i] = *(const float4*)(src + i * 256 + lane * 4);
      }
    }
    while (it >= 0) {
      const int itn = p1_item(c, ++k);
      if (itn >= 0) {
#pragma unroll
        for (int q = 0; q < 2; ++q) {
          const float* src = p.x + (size_t)(itn * 16 + wid * 2 + q) * 1024;
#pragma unroll
          for (int i = 0; i < 4; ++i) vn[q][i] = *(const float4*)(src + i * 256 + lane * 4);
        }
      }
      p1_rows<2>(p, v, it * 16 + wid * 2, lane);
#pragma unroll
      for (int q = 0; q < 2; ++q)
#pragma unroll
        for (int i = 0; i < 4; ++i) v[q][i] = vn[q][i];
      it = itn;
    }
  } else {
    for (int it = c; it < (NTOK + NCTX) / 16; it += G) {
      float4 v[2][4];
#pragma unroll
      for (int q = 0; q < 2; ++q) {
        const float* src = p1_src(p, it * 16 + wid * 2 + q);
#pragma unroll
        for (int i = 0; i < 4; ++i) v[q][i] = *(const float4*)(src + i * 256 + lane * 4);
      }
      p1_rows<2>(p, v, it * 16 + wid * 2, lane);
    }
  }
}

typedef float f32x2 __attribute__((ext_vector_type(2)));
template <int Q, int QEND>
__device__ __forceinline__ void hconv_step(const f32x2 (&in)[64], const f32x2 (&w)[31], const f32x2 bias, float* dst) {
  f32x2 a = bias;
  constexpr int KLO = (Q < 15) ? (15 - Q) : 0, KHI = (Q > 48) ? (79 - Q) : 31;
#pragma unroll
  for (int k = KLO; k < KHI; ++k) a += in[Q + k - 15] * w[k];
  *(unsigned*)((u16*)(dst + (size_t)Q * 1024)) = pack2(a.x, a.y);
  if constexpr (Q + 1 < QEND) hconv_step<Q + 1, QEND>(in, w, bias, dst);
}
template <bool DRY>
__device__ void p3_conv(const Params& p, int item, unsigned char* smem) {
  int tid_ = threadIdx.x;
  asm volatile("" : "+v"(tid_));
  const int tid = tid_, wid = __builtin_amdgcn_readfirstlane(tid >> 6), lane = tid & 63;
  const int b = item >> 5, r0 = ((item >> 1) & 15) * 4, c0 = (item & 1) * 32;
  const size_t tokb = (size_t)b * 4096;
  float* scrb = p.out + tokb * 1024;
  for (int rep = 0; rep < ((PROBE == 32) ? 2 : 1); ++rep) {
    const int t = tid & 255, sub = tid >> 8;
    const int ch = 512 + t * 2;
    const f32x2 bias = *(const f32x2*)(p.conv_db + ch);
    const int ri_lo = (r0 - 15) > 0 ? (r0 - 15) : 0, ri_hi = (r0 + 18) < 63 ? (r0 + 18) : 63;
    const int nst = ri_hi - ri_lo + 1;
    const int k0 = ri_lo - r0 + 15;
    const u16* vsrc = p.V + (tokb + c0 + wid * 4) * 1024 + 512 + lane * 8;
    LAS unsigned char* lds = (LAS unsigned char*)smem;
    f32x2 acc[4][16];
#pragma unroll
    for (int j = 0; j < 4; ++j)
#pragma unroll
      for (int q = 0; q < 16; ++q) acc[j][q] = bias;
    auto stage = [&](int ri, int slot) {
#pragma unroll
      for (int j = 0; j < 4; ++j)
        __builtin_amdgcn_global_load_lds((const unsigned*)(vsrc + (size_t)(ri * 64 + j) * 1024),
                                         (LAS unsigned*)(lds + slot * 32768 + (wid * 4 + j) * 1024), 16, 0, 0);
    };
    auto wtap = [&](int k) -> f32x2 {
      const int kc = k < 0 ? 0 : (k > 30 ? 30 : k);
      f32x2 w = *(const f32x2*)(p.conv_dw + kc * 1024 + ch);
      if (k < 0 || k > 30) w = (f32x2){0.f, 0.f};
      return w;
    };
    __syncthreads();
    f32x2 w0 = wtap(k0), w1 = wtap(k0 - 1), w2 = wtap(k0 - 2), w3 = wtap(k0 - 3);
    stage(ri_lo, 0);
    asm volatile("" ::: "memory");
    f32x2 wq1 = wtap(k0 + 1); stage(ri_lo + 1, 1);
    asm volatile("" ::: "memory");
    f32x2 wq2 = wtap(k0 + 2); stage(ri_lo + 2, 2);
    asm volatile("" ::: "memory");
#pragma unroll 1
    for (int s = 0; s < nst; ++s) {
      if (s + 2 < nst) asm volatile("s_waitcnt vmcnt(10)" ::: "memory");
      else asm volatile("s_waitcnt vmcnt(0)" ::: "memory");
      __syncthreads();
      f32x2 wn = (f32x2){0.f, 0.f};
      if (s + 3 < nst) { wn = wtap(k0 + s + 3); stage(ri_lo + s + 3, (s + 3) & 3); }
      const LAS unsigned* src = (const LAS unsigned*)(lds + (s & 3) * 32768 + sub * 16384 + t * 4);
#pragma unroll
      for (int q = 0; q < 16; ++q) {
        const unsigned raw = src[q * 256];
        f32x2 v; v.x = bflo(raw); v.y = bfhi(raw);
        acc[0][q] = __builtin_elementwise_fma(v, w0, acc[0][q]); acc[1][q] = __builtin_elementwise_fma(v, w1, acc[1][q]);
        acc[2][q] = __builtin_elementwise_fma(v, w2, acc[2][q]); acc[3][q] = __builtin_elementwise_fma(v, w3, acc[3][q]);
      }
      w3 = w2; w2 = w1; w1 = w0; w0 = wq1; wq1 = wq2; wq2 = wn;
    }
#pragma unroll
    for (int j = 0; j < 4; ++j)
#pragma unroll
      for (int q = 0; q < 16; ++q)
        *(unsigned*)((u16*)(scrb + (size_t)((r0 + j) * 64 + c0 + sub * 16 + q) * 1024) + ch) = pack2(acc[j][q].x, acc[j][q].y);
  }
  for (int rep = 0; rep < ((PROBE == 33) ? 2 : 1); ++rep) {
    const int t = tid & 255, rsel = tid >> 8;
    const int ch = t * 2;
    const f32x2 bias = *(const f32x2*)(p.conv_db + ch);
    f32x2 w[31];
#pragma unroll
    for (int k = 0; k < 31; ++k) w[k] = *(const f32x2*)(p.conv_dw + k * 1024 + ch);
#pragma unroll 1
    for (int rr = 0; rr < 2; ++rr) {
      const int row = r0 + rsel * 2 + rr;
      f32x2 in[64];
      {
        const u16* vrow = p.V + (tokb + row * 64) * 1024 + ch;
        unsigned raw[64];
#pragma unroll
        for (int q = 0; q < 64; ++q) raw[q] = *(const unsigned*)(vrow + (size_t)q * 1024);
#pragma unroll
        for (int q = 0; q < 64; ++q) { in[q].x = bflo(raw[q]); in[q].y = bfhi(raw[q]); }
      }
      float* dst = (float*)((u16*)(scrb + (size_t)(row * 64) * 1024) + ch);
      if (c0 == 0) hconv_step<0, 32>(in, w, bias, dst);
      else hconv_step<32, 64>(in, w, bias, dst);
    }
  }
  __syncthreads();
  float4 v[4][4], vn[4][4]; uint2 gt[4][4], gtn[4][4];
  auto ln_load = [&](int qb, float4 (&vv)[4][4], uint2 (&gg)[4][4]) {
#pragma unroll
    for (int u = 0; u < 4; ++u) {
      const int tk = wid * 16 + qb * 4 + u;
      const size_t tok = tokb + (r0 + (tk >> 5)) * 64 + c0 + (tk & 31);
      const float* src = p.out + tok * 1024;
      const u16* gd = p.SGC + tok * 1024;
#pragma unroll
      for (int i = 0; i < 4; ++i) {
        const uint2 raw = *(const uint2*)((const u16*)src + i * 256 + lane * 4);
        vv[u][i] = make_float4(bflo(raw.x), bfhi(raw.x), bflo(raw.y), bfhi(raw.y));
        gg[u][i] = *(const uint2*)(gd + i * 256 + lane * 4);
      }
    }
  };
  ln_load(0, v, gt);
#pragma unroll 1
  for (int qb = 0; qb < 4; ++qb) {
    if (qb < 3) ln_load(qb + 1, vn, gtn);
    float s1[4], s2[4];
#pragma unroll
    for (int u = 0; u < 4; ++u) {
      float a = 0.f, q = 0.f;
#pragma unroll
      for (int i = 0; i < 4; ++i) {
        a += (v[u][i].x + v[u][i].y) + (v[u][i].z + v[u][i].w);
        q += (v[u][i].x * v[u][i].x + v[u][i].y * v[u][i].y) + (v[u][i].z * v[u][i].z + v[u][i].w * v[u][i].w);
      }
      s1[u] = a; s2[u] = q;
    }
#pragma unroll
    for (int u = 0; u < 4; ++u) { s1[u] = wave_sum_fast(s1[u]); s2[u] = wave_sum_fast(s2[u]); }
#pragma unroll
    for (int u = 0; u < 4; ++u) {
      const int tk = wid * 16 + qb * 4 + u;
      const size_t tok = tokb + (r0 + (tk >> 5)) * 64 + c0 + (tk & 31);
      u16* gd = p.SGC + tok * 1024;
      const float mu = s1[u] * (1.f / 1024.f);
      const float var = fmaxf(s2[u] * (1.f / 1024.f) - mu * mu, 0.f);
      const float rstd = rsqrtf(var + EPS);
#pragma unroll
      for (int i = 0; i < 4; ++i) {
        const int idx = i * 256 + lane * 4;
        const float4 lgi = *(const float4*)(p.conv_ln_g + idx), lbi = *(const float4*)(p.conv_ln_b + idx);
        const float y0 = siluf_((v[u][i].x - mu) * rstd * lgi.x + lbi.x) * bflo(gt[u][i].x);
        const float y1 = siluf_((v[u][i].y - mu) * rstd * lgi.y + lbi.y) * bfhi(gt[u][i].x);
        const float y2 = siluf_((v[u][i].z - mu) * rstd * lgi.z + lbi.z) * bflo(gt[u][i].y);
        const float y3 = siluf_((v[u][i].w - mu) * rstd * lgi.w + lbi.w) * bfhi(gt[u][i].y);
        if (DRY) *(uint2*)((u16*)(p.out + tok * 1024) + idx) = make_uint2(pack2(y0, y1), pack2(y2, y3));
        else *(uint2*)(gd + idx) = make_uint2(pack2(y0, y1), pack2(y2, y3));
      }
    }
#pragma unroll
    for (int u = 0; u < 4; ++u)
#pragma unroll
      for (int i = 0; i < 4; ++i) { v[u][i] = vn[u][i]; gt[u][i] = gtn[u][i]; }
  }
}

struct ProbS {
  static constexpr int NT = 16; static constexpr bool PERM = false, A2 = false, B2 = false;
  Params p; int G, c;
  __device__ __forceinline__ bool next(int i, Unit& u) const {
    if (G == 256) {
      if (i > 0 || c >= 192) return false;
      const int j = c >> 3;
      u.aux = (j / 3) * 8 + (c & 7); u.pm = j % 3; u.pn = 0; return true;
    }
    const int L = i * G + c;
    if (L >= 192) return false;
    u.aux = L / 3; u.pm = L % 3; u.pn = 0; return true;
  }
  __device__ __forceinline__ unsigned avoff(int, int R, int C) const { return (unsigned)(R * 1024 + C) * 2u; }
  __device__ __forceinline__ unsigned bvoff(int, int R, int C) const { return (unsigned)(R * 1024 + C) * 2u; }
  __device__ __forceinline__ bool asel(int) const { return false; }
  __device__ __forceinline__ bool bsel(int) const { return false; }
  __device__ __forceinline__ const char* abase(const Unit& u, int h, int kt) const {
    return (const char*)p.Ug + ((size_t)u.aux * UGS + (size_t)(u.pm * 256 + h * 128) * 1024 + kt * 64) * 2;
  }
  __device__ __forceinline__ const char* bbase(const Unit& u, int h, int kt) const {
    return (const char*)p.BpowT + ((size_t)(h * 64 + u.aux) * 128 * 1024 + kt * 64) * 2;
  }
  __device__ __forceinline__ void epi(const f32x4 (&acc)[2][2][4][2], const Unit& u, int wr, int wc, int fr, int fq) const {
#pragma unroll
    for (int ai = 0; ai < 2; ++ai)
#pragma unroll
      for (int m = 0; m < 4; ++m) {
        const int row = u.pm * 256 + ai * 128 + wr * 64 + m * 16 + fr;
        if (row < UROWS) {
#pragma unroll
          for (int bj = 0; bj < 2; ++bj)
#pragma unroll
            for (int n = 0; n < 2; ++n)
              *(f32x4*)(p.S + ((size_t)(bj * 64 + u.aux) * UROWS + row) * 128 + wc * 32 + n * 16 + fq * 4) = acc[ai][bj][m][n];
        }
      }
  }
};

template <bool DRY>
__device__ void phase3(const Params& p, unsigned char* smem) {
  for (int rep = 0; rep < ((PROBE == 31) ? 2 : 1); ++rep) {
    ProbS P{p, (int)gridDim.x, (int)blockIdx.x};
    gemm_phase(( LAS unsigned char*)smem, P);
  }
  if (gridDim.x == 256) {
    const int c = blockIdx.x;
    const int j = c >> 3;
    p3_conv<DRY>(p, (c & 7) * 32 + j, smem);
    return;
  }
  int* sh_item = (int*)(smem + STAGE_BYTES);
  for (;;) {
    __syncthreads();
    if (threadIdx.x == 0) *sh_item = atomicAdd(p.ctr + (DRY ? 1 : 0), 1);
    __syncthreads();
    const int item = *sh_item;
    if (item >= 256) break;
    p3_conv<DRY>(p, item, smem);
  }
}

__device__ void phase4(const Params& p) {
  const int tid = threadIdx.x;
  for (int it = blockIdx.x; it < 128; it += gridDim.x) {
    int idx = it * 8 + (tid >> 6), pp = tid & 63;
    int d = idx >> 9, b = (idx >> 6) & 7, g = idx & 63;
    int dg = d * 64 + g;
    float lr = p.lam64[(dg * 64 + pp) * 2], li = p.lam64[(dg * 64 + pp) * 2 + 1];
    float hr = 0.f, hi = 0.f;
    const float* Sb = p.S + ((size_t)dg * UROWS + b * NCH) * 128;
    u16* Hb = p.Hp + ((size_t)g * 512 + b * 64) * 256 + d * 128;
#pragma unroll 1
    for (int cb = 0; cb < 4; ++cb) {
      float sr[17], si[17];
#pragma unroll
      for (int j = 0; j < 17; ++j) {
        const int step = cb * 17 + j;
        const int c = (d == 0) ? step : (step < 4 ? 3 - step : 71 - step);
        sr[j] = Sb[(size_t)c * 128 + pp]; si[j] = Sb[(size_t)c * 128 + 64 + pp];
      }
#pragma unroll
      for (int j = 0; j < 17; ++j) {
        const int step = cb * 17 + j;
        const int c = (d == 0) ? step : (step < 4 ? 3 - step : 71 - step);
        if (c >= 4) {
          Hb[(size_t)(c - 4) * 256 + pp] = f2bf(hr);
          Hb[(size_t)(c - 4) * 256 + 64 + pp] = f2bf(hi);
        }
        const float nr = lr * hr - li * hi + sr[j];
        const float ni = lr * hi + li * hr + si[j];
        hr = nr; hi = ni;
      }
    }
  }
}

struct ProbY {
  static constexpr int NT = 20; static constexpr bool PERM = true, A2 = true, B2 = true;
  Params p; int G, c;
  __device__ __forceinline__ bool next(int i, Unit& u) const {
    if (G == 256) {
      if (i > 1) return false;
      const int x = c & 7, j = c >> 3;
      u.aux = i * 32 + x * 4 + (j >> 3); u.pm = (j >> 2) & 1; u.pn = j & 3; return true;
    }
    const int L = i * G + c;
    if (L >= 512) return false;
    u.aux = L >> 3; u.pm = (L >> 2) & 1; u.pn = L & 3; return true;
  }
  __device__ __forceinline__ unsigned avoff(int s, int R, int C) const {
    return s ? (unsigned)(R * 256 + C) * 2u : (unsigned)(((R >> 6) * NCH + (R & 63)) * 1024 + C) * 2u;
  }
  __device__ __forceinline__ unsigned bvoff(int s, int R, int C) const {
    return s ? (unsigned)(R * 256 + C) * 2u : (unsigned)(((R >> 4) - (C >> 4) + 3) * 256 + (R & 15) * 16 + (C & 15)) * 2u;
  }
  __device__ __forceinline__ bool asel(int kt) const { return kt >= 16; }
  __device__ __forceinline__ bool bsel(int kt) const { return kt >= 16; }
  __device__ __forceinline__ const char* abase(const Unit& u, int h, int kt) const {
    if (kt < 16) return (const char*)p.Ug + ((size_t)u.aux * UGS + (size_t)((u.pm * 4 + h * 2) * NCH + 4) * 1024 + kt * 64) * 2;
    return (const char*)p.Hp + (((size_t)u.aux * 512 + u.pm * 256 + h * 128) * 256 + (kt - 16) * 64) * 2;
  }
  __device__ __forceinline__ const char* bbase(const Unit& u, int h, int kt) const {
    if (kt < 16) return (const char*)p.Kc + ((size_t)u.aux * 128 * 256 + (size_t)(u.pn * 16 + h * 8 - kt * 4 + 60) * 256) * 2;
    return (const char*)p.CpowT + (((size_t)u.aux * 1024 + u.pn * 256 + h * 128) * 256 + (kt - 16) * 64) * 2;
  }
  __device__ __forceinline__ void epi(const f32x4 (&acc)[2][2][4][2], const Unit& u, int wr, int wc, int fr, int fq) const {
    u16* Yact = p.Hb;
#pragma unroll
    for (int ai = 0; ai < 2; ++ai)
#pragma unroll
      for (int m = 0; m < 4; ++m) {
        const int rr = u.pm * 256 + ai * 128 + wr * 64 + m * 16 + fr;
        const int b = rr >> 6, cc = rr & 63;
#pragma unroll
        for (int bj = 0; bj < 2; ++bj) {
          const int t = u.pn * 16 + bj * 8 + wc * 2 + (fq >> 1);
          const size_t tok = (size_t)b * 4096 + cc * 64 + t;
          f32x4 v0, v1;
#pragma unroll
          for (int j = 0; j < 4; ++j) { v0[j] = gelu_tanh(acc[ai][bj][m][0][j]); v1[j] = gelu_tanh(acc[ai][bj][m][1][j]); }
          *(uint4*)(Yact + tok * 1024 + u.aux * 16 + (fq & 1) * 8) = pack8(v0, v1);
        }
      }
  }
};

template <bool DRY>
struct ProbGlu {
  static constexpr int NT = 16; static constexpr bool PERM = true, A2 = false, B2 = false;
  Params p; int G, c;
  __device__ __forceinline__ bool next(int i, Unit& u) const {
    const int L = i * G + c;
    if (L >= 512) return false;
    static_order(L, 128, 4, u.pm, u.pn); u.aux = 0; return true;
  }
  __device__ __forceinline__ unsigned avoff(int, int R, int C) const { return (unsigned)(R * 1024 + C) * 2u; }
  __device__ __forceinline__ unsigned bvoff(int, int R, int C) const { return (unsigned)(R * 1024 + C) * 2u; }
  __device__ __forceinline__ bool asel(int) const { return false; }
  __device__ __forceinline__ bool bsel(int) const { return false; }
  __device__ __forceinline__ const char* abase(const Unit& u, int h, int kt) const {
    return (const char*)p.Hb + ((size_t)(u.pm * 256 + h * 128) * 1024 + kt * 64) * 2;
  }
  __device__ __forceinline__ const char* bbase(const Unit& u, int h, int kt) const {
    return (const char*)p.GluT + ((size_t)(u.pn * 256 + h * 128) * 1024 + kt * 64) * 2;
  }
  __device__ __forceinline__ void epi(const f32x4 (&acc)[2][2][4][2], const Unit& u, int wr, int wc, int fr, int fq) const {
    const u16* Yact = p.Hb;
#pragma unroll
    for (int bj = 0; bj < 2; ++bj) {
      const int c0 = u.pn * 256 + bj * 128 + wc * 32 + fq * 8;
      const f32x4 gb0 = *(const f32x4*)(p.glu_b + c0), gb1 = *(const f32x4*)(p.glu_b + c0 + 4);
#pragma unroll
      for (int ai = 0; ai < 2; ++ai)
#pragma unroll
        for (int m = 0; m < 4; ++m) {
          const int r = u.pm * 256 + ai * 128 + wr * 64 + m * 16 + fr;
          const uint4 y = *(const uint4*)(Yact + (size_t)r * 1024 + c0);
          const uint4 s = *(const uint4*)(p.SGS + (size_t)r * 1024 + c0);
          const f32x4 a0 = acc[ai][bj][m][0] + gb0, a1 = acc[ai][bj][m][1] + gb1;
          f32x4 o0, o1;
          o0[0] = bflo(y.x) * sigmoidf_(a0[0]) * bflo(s.x); o0[1] = bfhi(y.x) * sigmoidf_(a0[1]) * bfhi(s.x);
          o0[2] = bflo(y.y) * sigmoidf_(a0[2]) * bflo(s.y); o0[3] = bfhi(y.y) * sigmoidf_(a0[3]) * bfhi(s.y);
          o1[0] = bflo(y.z) * sigmoidf_(a1[0]) * bflo(s.z); o1[1] = bfhi(y.z) * sigmoidf_(a1[1]) * bfhi(s.z);
          o1[2] = bflo(y.w) * sigmoidf_(a1[2]) * bflo(s.w); o1[3] = bfhi(y.w) * sigmoidf_(a1[3]) * bfhi(s.w);
          *(uint4*)((DRY ? p.V : p.SGS) + (size_t)r * 1024 + c0) = pack8(o0, o1);
        }
    }
  }
};

template <bool DRY>
struct ProbOut {
  static constexpr int NT = 32; static constexpr bool PERM = false, A2 = false, B2 = false;
  Params p; int G, c;
  __device__ __forceinline__ bool next(int i, Unit& u) const {
    const int L = i * G + c;
    if (L >= 512) return false;
    static_order(L, 128, 4, u.pm, u.pn); u.aux = 0; return true;
  }
  __device__ __forceinline__ unsigned avoff(int, int R, int C) const { return (unsigned)(R * 1024 + C) * 2u; }
  __device__ __forceinline__ unsigned bvoff(int, int R, int C) const { return (unsigned)(R * 2048 + C) * 2u; }
  __device__ __forceinline__ bool asel(int) const { return false; }
  __device__ __forceinline__ bool bsel(int) const { return false; }
  __device__ __forceinline__ const char* abase(const Unit& u, int h, int kt) const {
    return (const char*)p.SGC + (size_t)(kt >> 4) * NTOK * 1024 * 2 + ((size_t)(u.pm * 256 + h * 128) * 1024 + (kt & 15) * 64) * 2;
  }
  __device__ __forceinline__ const char* bbase(const Unit& u, int h, int kt) const {
    return (const char*)p.WoutT + ((size_t)(u.pn * 256 + h * 128) * 2048 + kt * 64) * 2;
  }
  bool fused;
  __device__ __forceinline__ void epi(f32x4 (&acc)[2][2][4][2], const Unit& u, int wr, int wc, int fr, int fq) const {
    const int col0 = u.pn * 256 + wc * 32 + fq * 4;
    {
      const float* gate = p.mod + ((u.pm * 256) >> 12) * 3072 + 2048 + col0;
      f32x4 gt[2][2];
#pragma unroll
      for (int bj = 0; bj < 2; ++bj)
#pragma unroll
        for (int n = 0; n < 2; ++n) gt[bj][n] = *(const f32x4*)(gate + bj * 128 + n * 16);
#pragma unroll
      for (int ai = 0; ai < 2; ++ai)
#pragma unroll
        for (int m = 0; m < 4; ++m) {
          const int r = u.pm * 256 + ai * 128 + wr * 64 + m * 16 + fr;
          const size_t off = (size_t)r * 1024 + col0;
          float sq = 0.f;
#pragma unroll
          for (int bj = 0; bj < 2; ++bj)
#pragma unroll
            for (int n = 0; n < 2; ++n) {
              const f32x4 xv = *(const f32x4*)(p.x + off + bj * 128 + n * 16);
              const f32x4 o = xv + gt[bj][n] * acc[ai][bj][m][n];
              sq += (o[0] * o[0] + o[1] * o[1]) + (o[2] * o[2] + o[3] * o[3]);
              if (DRY || !fused) *(f32x4*)(p.out + off + bj * 128 + n * 16) = o;
              else acc[ai][bj][m][n] = o;
            }
          sq += __shfl_xor(sq, 16);
          sq += __shfl_xor(sq, 32);
          if (fq == 0) { const float prev = atomicAdd((DRY ? p.S : p.rowsq) + r, sq); asm volatile("" :: "v"(prev)); }
        }
    }
    if (DRY || !fused) return;
    unsigned* cnt = (unsigned*)p.ctr + 256 + u.pm * 16 + wr * 8;
    asm volatile("s_waitcnt vmcnt(0)" ::: "memory");
    if ((threadIdx.x & 63) == 0) (void)__hip_atomic_fetch_add(cnt, 1u, __ATOMIC_RELAXED, __HIP_MEMORY_SCOPE_AGENT);
    {
      f32x4 fg[2][2];
#pragma unroll
      for (int bj = 0; bj < 2; ++bj)
#pragma unroll
        for (int n = 0; n < 2; ++n) fg[bj][n] = *(const f32x4*)(p.final_g + col0 + bj * 128 + n * 16);
      {
        unsigned sp = 0;
        while ((unsigned)__builtin_amdgcn_readfirstlane(__hip_atomic_load(cnt, __ATOMIC_RELAXED, __HIP_MEMORY_SCOPE_AGENT)) < 16u) {
          if (++sp > (1u << 18)) break;
        }
      }
#pragma unroll
      for (int ai = 0; ai < 2; ++ai)
#pragma unroll
        for (int m = 0; m < 4; ++m) {
          const int r = u.pm * 256 + ai * 128 + wr * 64 + m * 16 + fr;
          const size_t off = (size_t)r * 1024 + col0;
          const float tot = __uint_as_float(__hip_atomic_load((unsigned*)(p.rowsq + r), __ATOMIC_RELAXED, __HIP_MEMORY_SCOPE_AGENT));
          const float rs = rsqrtf(tot * (1.f / 1024.f) + EPS);
#pragma unroll
          for (int bj = 0; bj < 2; ++bj)
#pragma unroll
            for (int n = 0; n < 2; ++n) *(f32x4*)(p.out + off + bj * 128 + n * 16) = acc[ai][bj][m][n] * rs * fg[bj][n];
        }
    }
  }
};

template <bool DRY>
__device__ void phase8(const Params& p) {
  const int wid = threadIdx.x >> 6, lane = threadIdx.x & 63;
  constexpr int NIT = NTOK / 16;
  float4 v[2][4], vn[2][4];
  int it = blockIdx.x;
  if (it < NIT) {
#pragma unroll
    for (int q = 0; q < 2; ++q) {
      const float* row = p.out + (size_t)(it * 16 + wid * 2 + q) * 1024;
#pragma unroll
      for (int i = 0; i < 4; ++i) v[q][i] = *(const float4*)(row + i * 256 + lane * 4);
    }
  }
  for (; it < NIT; it += gridDim.x) {
    const int itn = it + gridDim.x;
    if (itn < NIT) {
#pragma unroll
      for (int q = 0; q < 2; ++q) {
        const float* row = p.out + (size_t)(itn * 16 + wid * 2 + q) * 1024;
#pragma unroll
        for (int i = 0; i < 4; ++i) vn[q][i] = *(const float4*)(row + i * 256 + lane * 4);
      }
    }
#pragma unroll
    for (int q = 0; q < 2; ++q) {
      const int r = it * 16 + wid * 2 + q;
      float rstd = DRY ? (p.rowsq[r] < -1.f ? 2.f : 1.f) : rsqrtf(p.rowsq[r] * (1.f / 1024.f) + EPS);
      float* row = p.out + (size_t)r * 1024;
#pragma unroll
      for (int i = 0; i < 4; ++i) {
        const int idx = i * 256 + lane * 4;
        float4 g = *(const float4*)(p.final_g + idx);
        if (DRY) g = make_float4(g.x < -100.f ? 2.f : 1.f, g.y < -100.f ? 2.f : 1.f, g.z < -100.f ? 2.f : 1.f, g.w < -100.f ? 2.f : 1.f);
        const float4 w = v[q][i];
        *(float4*)(row + idx) = make_float4(w.x * rstd * g.x, w.y * rstd * g.y, w.z * rstd * g.z, w.w * rstd * g.w);
      }
    }
#pragma unroll
    for (int q = 0; q < 2; ++q)
#pragma unroll
      for (int i = 0; i < 4; ++i) v[q][i] = vn[q][i];
  }
}

__global__ void __launch_bounds__(512, 2) mega_kernel(Params p) {
  extern __shared__ __attribute__((aligned(16))) unsigned char smem[];
  cg::grid_group grid = cg::this_grid();
  const int G = (int)gridDim.x, c = (int)blockIdx.x;
  volatile LAS unsigned* xst = (volatile LAS unsigned*)((LAS unsigned char*)smem + STAGE_BYTES + 16);
  if (threadIdx.x == 0) { xst[0] = 0u; xst[1] = 0u; }
  __syncthreads();
  const XcdBarrier xb = xcd_barrier_post(p.bar, xst);
#define GSYNC() xcd_barrier(xb)
  if (PROBE == 0) { phase0(p, smem); GSYNC(); }
  if (PROBE >= 10 && PROBE < 20) { phase0(p, smem, 1 << (PROBE - 10)); GSYNC(); }
  phase0(p, smem);
  if (p.bar == nullptr) grid.sync();
  GSYNC();
  if (PROBE == 1) { phase1(p, smem); GSYNC(); }
  phase1(p, smem); GSYNC();
  if (PROBE == 2) { ProbIn<0> P{p, G, c}; gemm_phase((LAS unsigned char*)smem, P); GSYNC(); }
  { ProbIn<0> P{p, G, c}; gemm_phase((LAS unsigned char*)smem, P); }
  if (G != 256) { ProbIn<2> P{p, G, c}; gemm_phase((LAS unsigned char*)smem, P); }
  GSYNC();
  if (PROBE == 3) { phase3<true>(p, smem); GSYNC(); }
  phase3<false>(p, smem); GSYNC();
  if (PROBE == 4) { phase4(p); GSYNC(); }
  phase4(p); GSYNC();
  if (PROBE == 5) { ProbY P{p, G, c}; gemm_phase((LAS unsigned char*)smem, P); GSYNC(); }
  { ProbY P{p, G, c}; gemm_phase((LAS unsigned char*)smem, P); } GSYNC();
  if (PROBE == 6) { ProbGlu<true> P{p, G, c}; gemm_phase((LAS unsigned char*)smem, P); GSYNC(); }
  { ProbGlu<false> P{p, G, c}; gemm_phase((LAS unsigned char*)smem, P); } GSYNC();
  const bool fused = (G == 256);
  if (PROBE == 7) { ProbOut<true> P{p, G, c, fused}; gemm_phase((LAS unsigned char*)smem, P); GSYNC(); }
  if (PROBE == 9) { GSYNC(); GSYNC(); GSYNC(); GSYNC(); GSYNC(); GSYNC(); GSYNC(); GSYNC(); }
  { ProbOut<false> P{p, G, c, fused}; gemm_phase((LAS unsigned char*)smem, P); }
  if (!fused) { GSYNC(); phase8<false>(p); }
}

static size_t align_up(size_t v) { return (v + 255) & ~(size_t)255; }
constexpr int LDS_BYTES = STAGE_BYTES + 256;

extern "C" void kernel_launch(void* const* d_in, const int* in_sizes, int n_in, void* d_out, int out_size, void* d_ws,
                              size_t ws_size, hipStream_t stream) {
  Params p{};
  const float** pin = (const float**)&p;
  for (int i = 0; i < 24; ++i) pin[i] = (const float*)d_in[i];
  p.out = (float*)d_out;
  unsigned char* w = (unsigned char*)d_ws;
  size_t off = 0;
  auto take = [&](size_t bytes) { unsigned char* r = w + off; off = align_up(off + bytes); return r; };
  p.mod = (float*)take(9 * 3072 * 4);
  p.rowsq = (float*)take((size_t)NTOK * 4);
  p.ctr = (int*)take(16384);
  p.bar = (unsigned*)take(XCD_BAR_WORDS * 4);
  p.lam64 = (float*)take(2 * 64 * 64 * 2 * 4);
  p.WinT = (u16*)take((size_t)5120 * 1024 * 2);
  p.GluT = (u16*)take((size_t)1024 * 1024 * 2);
  p.WoutT = (u16*)take((size_t)1024 * 2048 * 2);
  p.BpowT = (u16*)take((size_t)2 * 64 * 128 * 1024 * 2);
  p.CpowT = (u16*)take((size_t)64 * 1024 * 256 * 2);
  p.Kc = (u16*)take((size_t)64 * 128 * 256 * 2);
  p.Hb = (u16*)take((size_t)(NTOK + NCTX) * 1024 * 2);
  p.Hc = p.Hb + (size_t)NTOK * 1024;
  p.V = (u16*)take((size_t)NTOK * 1024 * 2);
  p.SGC = (u16*)take((size_t)NTOK * 1024 * 2 * 2);
  p.SGS = p.SGC + (size_t)NTOK * 1024;
  p.Ug = (u16*)take((size_t)64 * UGS * 2);
  p.S = (float*)take((size_t)2 * 64 * UROWS * 128 * 4);
  p.Hp = (u16*)take((size_t)64 * 512 * 256 * 2);
  if (off > ws_size) { fprintf(stderr, "kernel_launch: workspace too small: need %zu have %zu\n", off, ws_size); return; }
  static int grid = 0;
  if (!grid) {
    int dev = 0, cus = 0, per_cu = 0;
    hipGetDevice(&dev);
    hipDeviceGetAttribute(&cus, hipDeviceAttributeMultiprocessorCount, dev);
    hipFuncSetAttribute((const void*)mega_kernel, hipFuncAttributeMaxDynamicSharedMemorySize, LDS_BYTES);
    hipOccupancyMaxActiveBlocksPerMultiprocessor(&per_cu, (const void*)mega_kernel, 512, LDS_BYTES);
    (void)hipGetLastError();
    grid = cus;
  }
  (void)hipMemsetAsync(p.bar, 0, XCD_BAR_WORDS * 4, stream);
  void* args[] = {&p};
  hipError_t e = hipLaunchCooperativeKernel((const void*)mega_kernel, dim3(grid), dim3(512), args, LDS_BYTES, stream);
  if (e != hipSuccess) fprintf(stderr, "cooperative launch failed: %s (grid %d)\n", hipGetErrorString(e), grid);
}
```

```cpp
#include <hip/hip_runtime.h>
#include <hip/hip_bf16.h>
#include <hip/hip_cooperative_groups.h>
#include <cstdio>
namespace cg = cooperative_groups;

#ifndef MEGA
#define MEGA 1
#endif

#ifndef PROBE
#define PROBE -1
#endif
typedef unsigned short u16;
using bf16x8 = __attribute__((ext_vector_type(8))) short;
using f32x4 = __attribute__((ext_vector_type(4))) float;

constexpr int D_ = 1024, B_ = 8, L_ = 4096, CTX_ = 256;
constexpr int NTOK = B_ * L_;
constexpr int NCTX = B_ * CTX_;
constexpr int G_ = 64, P_ = 64, H_ = 16, T_ = 64;
constexpr int NCH = 68;
constexpr int UROWS = B_ * NCH;
constexpr size_t UGS = (size_t)UROWS * 1024;
constexpr float EPS = 1e-6f;

struct Params {
  const float *x, *c, *ctx, *c_ctx, *norm_g, *w_ada, *b_ada, *w_in, *conv_dw, *conv_db, *conv_ln_g, *conv_ln_b,
      *a_re, *a_im, *log_dt, *b_re, *b_im, *c_re, *c_im, *ssm_d, *glu_w, *glu_b, *w_out, *final_g;
  float* out;
  float *mod, *rowsq, *lam64, *S;
  int* ctr;
  unsigned* bar;
  u16 *WinT, *GluT, *WoutT, *BpowT, *CpowT, *Kc, *Hb, *Hc, *V, *SGC, *SGS, *Ug, *Hp;
};

__device__ __forceinline__ u16 f2bf(float f) {
  unsigned u = __float_as_uint(f);
  u += 0x7fffu + ((u >> 16) & 1u);
  return (u16)(u >> 16);
}
__device__ __forceinline__ float bf2f(u16 h) { return __uint_as_float(((unsigned)h) << 16); }
__device__ __forceinline__ float bflo(unsigned u) { return __uint_as_float(u << 16); }
__device__ __forceinline__ float bfhi(unsigned u) { return __uint_as_float(u & 0xffff0000u); }
__device__ __forceinline__ unsigned pack2(float a, float b) { unsigned r; asm("v_cvt_pk_bf16_f32 %0, %1, %2" : "=v"(r) : "v"(a), "v"(b)); return r; }
__device__ __forceinline__ float sigmoidf_(float x) { return __builtin_amdgcn_rcpf(1.f + __builtin_amdgcn_exp2f(-1.4426950408889634f * x)); }
__device__ __forceinline__ float siluf_(float x) { return x * sigmoidf_(x); }
__device__ __forceinline__ float gelu_tanh(float x) {
  float z = 0.7978845608028654f * (x + 0.044715f * x * x * x);
  return x * __builtin_amdgcn_rcpf(1.f + __builtin_amdgcn_exp2f(-2.885390081777927f * z));
}
__device__ __forceinline__ float wave_sum(float v) {
#pragma unroll
  for (int o = 32; o >= 1; o >>= 1) v += __shfl_xor(v, o);
  return v;
}

template <int CTRL>
__device__ __forceinline__ float dpp_add(float v) {
  return v + __int_as_float(__builtin_amdgcn_update_dpp(0, __float_as_int(v), CTRL, 0xf, 0xf, true));
}
__device__ __forceinline__ float wave_sum_fast(float v) {
  v = dpp_add<0xB1>(v); v = dpp_add<0x4E>(v); v = dpp_add<0x141>(v); v = dpp_add<0x140>(v);
  const int iv = __float_as_int(v);
  return (__int_as_float(__builtin_amdgcn_readlane(iv, 0)) + __int_as_float(__builtin_amdgcn_readlane(iv, 16))) +
         (__int_as_float(__builtin_amdgcn_readlane(iv, 32)) + __int_as_float(__builtin_amdgcn_readlane(iv, 48)));
}

__device__ __forceinline__ void lam_pow(float a_re, float a_im, double dt, int e, double& pr, double& pi) {
  double ang = (double)e * dt * (double)a_im;
  ang -= 6.283185307179586476925 * rint(ang * 0.15915494309189533577);
  float mag = expf((float)((double)e * dt * (double)a_re));
  float s, c;
  sincosf((float)ang, &s, &c);
  pr = (double)(mag * c); pi = (double)(mag * s);
}
__device__ __forceinline__ void zoh_coef(float a_re, float a_im, double dt, double& cr, double& ci) {
  double ang = dt * (double)a_im;
  double mag = exp(dt * (double)a_re);
  double s, c;
  sincos(ang, &s, &c);
  double nr = mag * c - 1.0, ni = mag * s;
  double dr = (double)a_re, di = (double)a_im;
  double den = dr * dr + di * di;
  cr = (nr * dr + ni * di) / den;
  ci = (ni * dr - nr * di) / den;
}
__device__ __forceinline__ double dt_of(const float* log_dt, int dg) { return (double)expf(log_dt[dg]); }
__device__ __forceinline__ void lam_powf(float a_re, float a_im, double dt, int e, float& pr, float& pi) {
  double ang = (double)e * dt * (double)a_im;
  ang -= 6.283185307179586476925 * rint(ang * 0.15915494309189533577);
  const float mag = expf((float)e * (float)dt * a_re);
  float sn, cs;
  sincosf((float)ang, &sn, &cs);
  pr = mag * cs; pi = mag * sn;
}

#define LAS __attribute__((address_space(3)))
constexpr int HTB = 128 * 64 * 2;
constexpr int STAGE_BYTES = 8 * HTB;
__device__ __forceinline__ int lds_byte(int r, int c) {
  int st = (r >> 4) * 2 + (c >> 5), rr = r & 15, cc = c & 31, ob = rr * 64 + cc * 2;
  return st * 1024 + (ob ^ (((ob >> 9) & 1) << 5));
}
__device__ __forceinline__ void stage_rc(int b, int& R, int& C) {
  int st = b / 1024, sb = b % 1024, swz = sb ^ (((sb >> 9) & 1) << 5);
  R = (st >> 1) * 16 + swz / 64;
  C = (st & 1) * 32 + (swz % 64) / 2;
}
__device__ __forceinline__ int perm32(int rho) { const int n = rho >> 4, i = rho & 15; return 8 * (i >> 2) + 4 * n + (i & 3); }
struct Unit { int pm, pn, aux; };

template <int WGM = 8>
__device__ __forceinline__ void static_order(int L, int nM, int nN, int& pm, int& pn) {
  const int nwg = nM * nN;
  int wgid = L;
  { const int q = nwg / 8, r = nwg % 8, xcd = wgid % 8, off = wgid / 8; wgid = (xcd < r ? xcd * (q + 1) : r * (q + 1) + (xcd - r) * q) + off; }
  const int nig = WGM * nN, gid = wgid / nig, fm = gid * WGM, gsz = (nM - fm) < WGM ? (nM - fm) : WGM;
  pm = fm + ((wgid % nig) % gsz); pn = (wgid % nig) / gsz;
}

template <class Prob>
__device__ __forceinline__ void gemm_phase(LAS unsigned char* lds, const Prob& P) {
  int tid_ = threadIdx.x;
  asm volatile("" : "+v"(tid_));
  const int tid = tid_, wid = __builtin_amdgcn_readfirstlane(tid >> 6), lane = tid & 63, wr = wid >> 2, wc = wid & 3, fr = lane & 15, fq = lane >> 4;
  constexpr int nt = Prob::NT;
  unsigned voA0[2], voA1[2], voB0[2], voB1[2];
#pragma unroll
  for (int i = 0; i < 2; ++i) {
    int R, C; stage_rc(tid * 16 + i * 8192, R, C);
    const int Rb = Prob::PERM ? ((R & ~31) + perm32(R & 31)) : R;
    voA0[i] = P.avoff(0, R, C); voA1[i] = Prob::A2 ? P.avoff(1, R, C) : 0u;
    voB0[i] = P.bvoff(0, Rb, C); voB1[i] = Prob::B2 ? P.bvoff(1, Rb, C) : 0u;
  }
  const unsigned ldsw = (unsigned)wid * 1024u;
  const int aoff = lds_byte(wr * 64 + fr, fq * 8), boff = lds_byte(wc * 32 + fr, fq * 8);
#define G_SA(b, h) (((b) * 2 + (h)) * HTB)
#define G_SB(b, h) ((4 + (b) * 2 + (h)) * HTB)
#define G_STAGE_A(bufoff, u, h, kt) do { const char* _g = P.abase(u, h, kt); const bool _s = Prob::A2 && P.asel(kt); \
    _Pragma("unroll") for (int _i = 0; _i < 2; ++_i) __builtin_amdgcn_global_load_lds((const unsigned*)(_g + (_s ? voA1[_i] : voA0[_i])), (LAS unsigned*)(lds + (bufoff) + ldsw + _i * 8192), 16, 0, 0); } while (0)
#define G_STAGE_B(bufoff, u, h, kt) do { const char* _g = P.bbase(u, h, kt); const bool _s = Prob::B2 && P.bsel(kt); \
    _Pragma("unroll") for (int _i = 0; _i < 2; ++_i) __builtin_amdgcn_global_load_lds((const unsigned*)(_g + (_s ? voB1[_i] : voB0[_i])), (LAS unsigned*)(lds + (bufoff) + ldsw + _i * 8192), 16, 0, 0); } while (0)
#define G_LDA(dst, b, h) do { _Pragma("unroll") for (int m = 0; m < 4; ++m) _Pragma("unroll") for (int k = 0; k < 2; ++k) dst[m][k] = *(const LAS bf16x8*)(lds + G_SA(b, h) + aoff + m * 2048 + k * 1024); } while (0)
#define G_LDB(dst, b, h) do { _Pragma("unroll") for (int n = 0; n < 2; ++n) _Pragma("unroll") for (int k = 0; k < 2; ++k) dst[n][k] = *(const LAS bf16x8*)(lds + G_SB(b, h) + boff + n * 2048 + k * 1024); } while (0)
#define G_MMA(ai, bj, At, Bt) do { __builtin_amdgcn_s_setprio(1); _Pragma("unroll") for (int m = 0; m < 4; ++m) _Pragma("unroll") for (int n = 0; n < 2; ++n) _Pragma("unroll") for (int k = 0; k < 2; ++k) \
    acc[ai][bj][m][n] = __builtin_amdgcn_mfma_f32_16x16x32_bf16(Bt[n][k], At[m][k], acc[ai][bj][m][n], 0, 0, 0); __builtin_amdgcn_s_setprio(0); } while (0)
#define G_WAIT_V(n) asm volatile("s_waitcnt vmcnt(" #n ")" ::: "memory")
#define G_WAIT_L(n) asm volatile("s_waitcnt lgkmcnt(" #n ")" ::: "memory")
#define G_BAR __builtin_amdgcn_s_barrier()
#define G_SCHED __builtin_amdgcn_sched_barrier(0)
  Unit cur, nxt; int ui = 0;
  if (!P.next(0, cur)) return;
  f32x4 acc[2][2][4][2];
#pragma unroll
  for (int a = 0; a < 2; ++a)
#pragma unroll
    for (int b = 0; b < 2; ++b)
#pragma unroll
      for (int m = 0; m < 4; ++m)
#pragma unroll
        for (int n = 0; n < 2; ++n) acc[a][b][m][n] = (f32x4){0.f, 0.f, 0.f, 0.f};
  bf16x8 At[4][2], B0[2][2], B1[2][2];
  G_STAGE_B(G_SB(0, 0), cur, 0, 0); G_STAGE_A(G_SA(0, 0), cur, 0, 0); G_STAGE_B(G_SB(0, 1), cur, 1, 0); G_STAGE_A(G_SA(0, 1), cur, 1, 0);
  if (wr == 1) G_BAR;
  G_WAIT_V(4); G_BAR;
  G_STAGE_B(G_SB(1, 0), cur, 0, 1); G_STAGE_A(G_SA(1, 0), cur, 0, 1); G_STAGE_B(G_SB(1, 1), cur, 1, 1);
  G_WAIT_V(6); G_BAR;
  for (;;) {
    const bool has_next = P.next(ui + 1, nxt);
    const Unit nu = has_next ? nxt : cur;
    for (int t = 0; t < nt; t += 2) {
      const bool last = (t == nt - 2);
      const Unit u2 = last ? nu : cur;
      const int k2 = last ? 0 : t + 2, k3 = k2 + 1;
      G_LDB(B0, 0, 0); G_SCHED; G_LDA(At, 0, 0); G_STAGE_A(G_SA(1, 1), cur, 1, t + 1);
      G_WAIT_L(8); G_BAR; G_WAIT_L(0); G_MMA(0, 0, At, B0); G_BAR; G_SCHED;
      G_LDB(B1, 0, 1); G_STAGE_B(G_SB(0, 0), u2, 0, k2);
      G_BAR; G_WAIT_L(0); G_MMA(0, 1, At, B1); G_BAR;
      G_LDA(At, 0, 1); G_STAGE_A(G_SA(0, 0), u2, 0, k2);
      G_BAR; G_WAIT_L(0); G_MMA(1, 0, At, B0); G_BAR; G_SCHED;
      G_STAGE_B(G_SB(0, 1), u2, 1, k2);
      G_WAIT_V(6); G_BAR; G_MMA(1, 1, At, B1); G_BAR;
      G_LDB(B0, 1, 0); G_SCHED; G_LDA(At, 1, 0); G_STAGE_A(G_SA(0, 1), u2, 1, k2);
      G_WAIT_L(8); G_BAR; G_WAIT_L(0); G_MMA(0, 0, At, B0); G_BAR; G_SCHED;
      G_LDB(B1, 1, 1); G_STAGE_B(G_SB(1, 0), u2, 0, k3);
      G_BAR; G_WAIT_L(0); G_MMA(0, 1, At, B1); G_BAR;
      G_LDA(At, 1, 1); G_STAGE_A(G_SA(1, 0), u2, 0, k3);
      G_BAR; G_WAIT_L(0); G_MMA(1, 0, At, B0); G_BAR; G_SCHED;
      G_STAGE_B(G_SB(1, 1), u2, 1, k3);
      G_WAIT_V(6); G_BAR; G_MMA(1, 1, At, B1); G_BAR;
    }
    P.epi(acc, cur, wr, wc, fr, fq);
    if (!has_next) break;
#pragma unroll
    for (int a = 0; a < 2; ++a)
#pragma unroll
      for (int b = 0; b < 2; ++b)
#pragma unroll
        for (int m = 0; m < 4; ++m)
#pragma unroll
          for (int n = 0; n < 2; ++n) acc[a][b][m][n] = (f32x4){0.f, 0.f, 0.f, 0.f};
    cur = nxt; ++ui;
  }
  G_WAIT_V(0);
  if (wr == 0) G_BAR;
  G_BAR;
}


#define XB_TMO      128
#define XB_XCNT(j)  (256  + 64 * (j))
#define XB_XSUB(j)  (1280 + 64 * (j))
#define XB_XGEN(j)  (2304 + 64 * (j))
#define XB_TOP      3328
#define XB_TOPGEN   3392
#define XCD_BAR_WORDS 3456
#define XB_SPIN_CAP (1u << 18)
__device__ __forceinline__ unsigned xb_ld(unsigned* p)              { return __hip_atomic_load(p, __ATOMIC_RELAXED, __HIP_MEMORY_SCOPE_AGENT); }
__device__ __forceinline__ unsigned xb_add(unsigned* p, unsigned v) { return __hip_atomic_fetch_add(p, v, __ATOMIC_RELAXED, __HIP_MEMORY_SCOPE_AGENT); }
__device__ __forceinline__ unsigned xb_xcc_id() { return (unsigned)__builtin_amdgcn_s_getreg((3 << 11) | 20) & 0xFu; }
#define XB_SPIN(cond, bar) do { unsigned _sp = 0; while (cond) { __builtin_amdgcn_s_sleep(1); \
    if ((++_sp & 255u) == 0u) { if (xb_ld(&(bar)[XB_TMO])) break; if (_sp > XB_SPIN_CAP) { atomicAdd(&(bar)[XB_TMO], 1u); break; } } } } while (0)
struct XcdBarrier { unsigned* bar; unsigned x; volatile LAS unsigned* st; };
__device__ __forceinline__ XcdBarrier xcd_barrier_post(unsigned* bar, volatile LAS unsigned* st) {
  XcdBarrier b; b.bar = bar; b.x = xb_xcc_id(); b.st = st;
  if (threadIdx.x == 0) (void)xb_add(&bar[XB_XCNT(b.x)], 1u);
  return b;
}
__device__ __forceinline__ void xcd_barrier_complete(unsigned* bar, unsigned x, unsigned& nloc, unsigned& nx) {
  const unsigned G = gridDim.x * gridDim.y * gridDim.z;
  unsigned sum, cnt, mine, sp = 0u;
  for (;;) {
    sum = 0u; cnt = 0u; mine = 0u;
#pragma unroll
    for (unsigned j = 0; j < 16; ++j) { const unsigned c = xb_ld(&bar[XB_XCNT(j)]); sum += c; cnt += (c > 0u) ? 1u : 0u; mine = (j == x) ? c : mine; }
    if (sum == G) break;
    __builtin_amdgcn_s_sleep(1);
    if ((++sp & 255u) == 0u) { if (xb_ld(&bar[XB_TMO])) break; if (sp > XB_SPIN_CAP) { atomicAdd(&bar[XB_TMO], 1u); break; } }
  }
  nloc = mine > 0u ? mine : 1u; nx = cnt > 0u ? cnt : 1u;
}
__device__ __forceinline__ void xcd_barrier(const XcdBarrier& b) {
  asm volatile("s_waitcnt vmcnt(0)" ::: "memory");
  __syncthreads();
  if (threadIdx.x == 0) {
    unsigned* bar = b.bar;
    __builtin_amdgcn_s_waitcnt(0);
    unsigned nloc = b.st[0], nx = b.st[1];
    if (nloc == 0u) { xcd_barrier_complete(bar, b.x, nloc, nx); b.st[0] = nloc; b.st[1] = nx; }
    const unsigned old = xb_add(&bar[XB_XSUB(b.x)], 1u);
    const unsigned gen = old / nloc;
    if (old + 1u == (gen + 1u) * nloc) {
      __builtin_amdgcn_fence(__ATOMIC_RELEASE, "agent");
      asm volatile("s_waitcnt vmcnt(0)" ::: "memory");
      const unsigned og = xb_add(&bar[XB_TOP], 1u);
      const unsigned tg = og / nx;
      if (og + 1u == (tg + 1u) * nx) xb_add(&bar[XB_TOPGEN], 1u);
      else XB_SPIN(xb_ld(&bar[XB_TOPGEN]) == tg, bar);
      __builtin_amdgcn_fence(__ATOMIC_ACQUIRE, "agent");
      xb_add(&bar[XB_XGEN(b.x)], 1u);
      asm volatile("s_waitcnt vmcnt(0)" ::: "memory");
    } else {
      XB_SPIN(xb_ld(&bar[XB_XGEN(b.x)]) == gen, bar);
      __builtin_amdgcn_fence(__ATOMIC_ACQUIRE, "agent");
      asm volatile("s_waitcnt vmcnt(0)" ::: "memory");
    }
  }
  __syncthreads();
}

__device__ __forceinline__ uint4 pack8(const f32x4& a, const f32x4& b) {
  return make_uint4(pack2(a[0], a[1]), pack2(a[2], a[3]), pack2(b[0], b[1]), pack2(b[2], b[3]));
}
__device__ void p0_mod(const Params& p, int item, unsigned char* smem) {
  float* s = (float*)smem;
  float* red = s + 9 * 1024;
  int tid_o = threadIdx.x; asm volatile("" : "+v"(tid_o)); const int tid = tid_o & 255;
  for (int i = tid; i < 9 * 1024; i += 256) {
    int r = i >> 10, k = i & 1023;
    float v = (r < 8) ? p.c[r * 1024 + k] : p.c_ctx[k];
    s[i] = siluf_(v);
  }
  __syncthreads();
  const int ks = tid >> 4, cl = tid & 15, j = item * 16 + cl;
  float acc[9];
#pragma unroll
  for (int r = 0; r < 9; ++r) acc[r] = 0.f;
  for (int k = ks * 64; k < ks * 64 + 64; ++k) {
    float w = p.w_ada[(size_t)k * 3072 + j];
#pragma unroll
    for (int r = 0; r < 9; ++r) acc[r] += s[r * 1024 + k] * w;
  }
#pragma unroll
  for (int r = 0; r < 9; ++r) red[(ks * 16 + cl) * 9 + r] = acc[r];
  __syncthreads();
  if (tid < 144) {
    int r = tid >> 4, c2 = tid & 15, jj = item * 16 + c2;
    float a = p.b_ada[jj];
    for (int q = 0; q < 16; ++q) a += red[(q * 16 + c2) * 9 + r];
    p.mod[r * 3072 + jj] = a;
  }
  __syncthreads();
}

template <bool PERM>
__device__ void p0_transpose(const float* src, int N, u16* dst, int Kd, int kt, int nt, unsigned char* smem) {
  float* t = (float*)smem;
  int tid_o = threadIdx.x; asm volatile("" : "+v"(tid_o)); const int tid = tid_o & 255;
#pragma unroll
  for (int i = 0; i < 16; ++i) {
    int e = i * 256 + tid, kr = e >> 6, nc = e & 63;
    t[kr * 65 + nc] = src[(size_t)(kt * 64 + kr) * N + nt * 64 + nc];
  }
  __syncthreads();
  {
    int nl = tid >> 2, kq = tid & 3;
    int n = nt * 64 + nl, np = n;
    if (PERM) {
      if (n < 2048) {
        int sec = n >> 10, ch = n & 1023;
        np = (ch >> 7) * 256 + sec * 128 + (ch & 127);
      }
    }
    unsigned w[8];
#pragma unroll
    for (int q = 0; q < 8; ++q) w[q] = pack2(t[(kq * 16 + q * 2) * 65 + nl], t[(kq * 16 + q * 2 + 1) * 65 + nl]);
    uint4* d = (uint4*)(dst + (size_t)np * Kd + kt * 64 + kq * 16);
    d[0] = make_uint4(w[0], w[1], w[2], w[3]);
    d[1] = make_uint4(w[4], w[5], w[6], w[7]);
  }
  __syncthreads();
}

__device__ void p0_bpow(const Params& p, int item) {
  int tid_o = threadIdx.x; asm volatile("" : "+v"(tid_o)); const int tid = tid_o & 255;
  int dg = item >> 3, nb = item & 7;
  int n = nb * 16 + (tid >> 4), ri = n >> 6, pp = n & 63;
  int d = dg >> 6;
  int s0 = (tid & 15) * 4;
  double dt = dt_of(p.log_dt, dg);
  float are = p.a_re[dg * 64 + pp], aim = p.a_im[dg * 64 + pp];
  double cr, ci;
  zoh_coef(are, aim, dt, cr, ci);
  const float* br = p.b_re + ((size_t)dg * 64 + pp) * 16;
  const float* bi = p.b_im + ((size_t)dg * 64 + pp) * 16;
  u16* dst = p.BpowT + ((size_t)dg * 128 + n) * 1024 + s0 * 16;
  const float cfr = (float)cr, cfi = (float)ci;
  float brv[16], biv[16];
#pragma unroll
  for (int h = 0; h < 16; ++h) { brv[h] = br[h]; biv[h] = bi[h]; }
  for (int q = 0; q < 4; ++q) {
    int s = s0 + q;
    int e = (d == 0) ? (63 - s) : s;
    float lr, li;
    lam_powf(are, aim, dt, e, lr, li);
    const float wr_ = lr * cfr - li * cfi, wi_ = lr * cfi + li * cfr;
    unsigned w[8];
#pragma unroll
    for (int h2 = 0; h2 < 8; ++h2) {
      float v0, v1;
      if (ri == 0) { v0 = wr_ * brv[h2 * 2] - wi_ * biv[h2 * 2]; v1 = wr_ * brv[h2 * 2 + 1] - wi_ * biv[h2 * 2 + 1]; }
      else         { v0 = wr_ * biv[h2 * 2] + wi_ * brv[h2 * 2]; v1 = wr_ * biv[h2 * 2 + 1] + wi_ * brv[h2 * 2 + 1]; }
      w[h2] = pack2(v0, v1);
    }
    uint4* dd = (uint4*)(dst + q * 16);
    dd[0] = make_uint4(w[0], w[1], w[2], w[3]);
    dd[1] = make_uint4(w[4], w[5], w[6], w[7]);
  }
}

__device__ void p0_cpow(const Params& p, int item) {
  int tid_o = threadIdx.x; asm volatile("" : "+v"(tid_o)); const int tid = tid_o & 255;
  int g = item >> 6, t = item & 63;
  int d = tid >> 7, ri = (tid >> 6) & 1, pp = tid & 63;
  int dg = d * 64 + g;
  double dt = dt_of(p.log_dt, dg);
  float are = p.a_re[dg * 64 + pp], aim = p.a_im[dg * 64 + pp];
  int e = (d == 0) ? (t + 1) : (64 - t);
  float lr, li;
  lam_powf(are, aim, dt, e, lr, li);
  float crv[16], civ[16];
#pragma unroll
  for (int hp = 0; hp < 16; ++hp) { crv[hp] = p.c_re[((size_t)dg * 16 + hp) * 64 + pp]; civ[hp] = p.c_im[((size_t)dg * 16 + hp) * 64 + pp]; }
#pragma unroll
  for (int hp = 0; hp < 16; ++hp) {
    const float wr_ = crv[hp] * lr - civ[hp] * li, wi_ = crv[hp] * li + civ[hp] * lr;
    p.CpowT[((size_t)g * 1024 + t * 16 + hp) * 256 + tid] = f2bf((ri == 0) ? wr_ : -wi_);
  }
}

__device__ void p0_kc(const Params& p, int item, unsigned char* smem) {
  float2* Cs = (float2*)smem;
  float2* Bs = Cs + 2 * 16 * 65;
  float4* Ws = (float4*)(Bs + 2 * 64 * 16);
  int tid_o = threadIdx.x; asm volatile("" : "+v"(tid_o)); const int tid = tid_o & 255;
  const int g = item >> 3, blk = item & 7;
  const int dm = (blk <= 3) ? 1 : 0;
  __syncthreads();
  for (int i = tid; i < 2 * 1024; i += 256) {
    int d = i >> 10, j = i & 1023, dg = d * 64 + g;
    int hp = j >> 6, pp = j & 63;
    Cs[(d * 16 + hp) * 65 + pp] = make_float2(p.c_re[(size_t)dg * 1024 + j], p.c_im[(size_t)dg * 1024 + j]);
  }
  if (tid < 128) {
    int d = tid >> 6, pp = tid & 63, dg = d * 64 + g;
    double dt = dt_of(p.log_dt, dg);
    float are = p.a_re[dg * 64 + pp], aim = p.a_im[dg * 64 + pp];
    double cr, ci;
    zoh_coef(are, aim, dt, cr, ci);
    const float cfr = (float)cr, cfi = (float)ci;
    const float* br = p.b_re + ((size_t)dg * 64 + pp) * 16;
    const float* bi = p.b_im + ((size_t)dg * 64 + pp) * 16;
    for (int h = 0; h < 16; ++h) {
      const float b_r = br[h], b_i = bi[h];
      Bs[(d * 64 + pp) * 16 + h] = make_float2(cfr * b_r - cfi * b_i, cfr * b_i + cfi * b_r);
    }
  }
  {
    const int dg = dm * 64 + g;
    const double dt = dt_of(p.log_dt, dg);
    for (int i = tid; i < 1024; i += 256) {
      int sl = i >> 6, pp = i & 63, ti = blk * 16 + sl, tau = ti - 63;
      int e = tau < 0 ? -tau : tau;
      float lr, li;
      lam_powf(p.a_re[dg * 64 + pp], p.a_im[dg * 64 + pp], dt, e, lr, li);
      float2* wp = (float2*)(Ws + pp * 8 + (sl >> 1)) + (sl & 1);
      *wp = make_float2(lr, li);
    }
  }
  __syncthreads();
  const int hp = tid >> 4, h = tid & 15;
  float acc[16];
#pragma unroll
  for (int sl = 0; sl < 16; ++sl) acc[sl] = 0.f;
  {
    const float2* cr = Cs + (dm * 16 + hp) * 65;
    const float2* bb = Bs + dm * 1024 + h;
#pragma unroll 1
    for (int pp = 0; pp < 64; ++pp) {
      const float2 c = cr[pp], b = bb[pp * 16];
      const float zr = c.x * b.x - c.y * b.y, zi = c.x * b.y + c.y * b.x;
#pragma unroll
      for (int j = 0; j < 8; ++j) {
        const float4 w = Ws[pp * 8 + j];
        acc[2 * j] += w.x * zr - w.y * zi;
        acc[2 * j + 1] += w.z * zr - w.w * zi;
      }
    }
  }
  if (blk == 3) {
    const float2* cr = Cs + hp * 65;
    const float2* bb = Bs + h;
    float e0 = 0.f;
#pragma unroll 4
    for (int pp = 0; pp < 64; ++pp) { const float2 c = cr[pp], b = bb[pp * 16]; e0 += c.x * b.x - c.y * b.y; }
    acc[15] += e0 + ((hp == h) ? p.ssm_d[g * 16 + h] : 0.f);
  }
#pragma unroll
  for (int sl = 0; sl < 16; ++sl) {
    const int ti = blk * 16 + sl;
    if (ti < 127) p.Kc[((size_t)g * 128 + ti) * 256 + tid] = f2bf(acc[sl]);
  }
  __syncthreads();
}

__device__ void p0_misc(const Params& p, int item) {
  int tid_o = threadIdx.x; asm volatile("" : "+v"(tid_o)); const int tid = tid_o & 255;
  if (item < 32) {
    int idx = item * 256 + tid;
    int dg = idx >> 6;
    double dt = dt_of(p.log_dt, dg);
    double lr, li;
    lam_pow(p.a_re[idx], p.a_im[idx], dt, 64, lr, li);
    p.lam64[idx * 2] = (float)lr;
    p.lam64[idx * 2 + 1] = (float)li;
  } else if (item < 64) {
    int idx = (item - 32) * 1024 + tid * 4;
    *(float4*)(p.rowsq + idx) = make_float4(0.f, 0.f, 0.f, 0.f);
  } else if (item == 64) {
#pragma unroll
    for (int i = 0; i < 4; ++i) *(int4*)(p.ctr + i * 1024 + tid * 4) = make_int4(0, 0, 0, 0);
  }
}


constexpr int P0_MOD = 192, P0_TIN = 16 * 80, P0_TGLU = 16 * 16, P0_TOUT = 32 * 16, P0_BPOW = 1024, P0_CPOW = 4096,
              P0_KC = 64 * 8, P0_MISC = 66;
__device__ void phase0(const Params& p, unsigned char* smem0, const int mask = 0xff) {
  constexpr int o1 = P0_MOD, o2 = o1 + P0_KC, o3 = o2 + P0_TIN, o4 = o3 + P0_TGLU, o5 = o4 + P0_TOUT, o6 = o5 + P0_BPOW,
                o7 = o6 + P0_CPOW, o8 = o7 + P0_MISC;
  const int hb = threadIdx.x >> 8;
  unsigned char* smem = smem0 + hb * 65536;
  for (int it2 = blockIdx.x; it2 < o8 / 2; it2 += gridDim.x) {
    const int it = it2 * 2 + hb;
    if (it < o1) { if (mask & 1) p0_mod(p, it, smem); }
    else if (it < o2) { if (mask & 2) p0_kc(p, it - o1, smem); }
    else if (it < o3) { if (mask & 4) { int i = it - o2; p0_transpose<true>(p.w_in, 5120, p.WinT, 1024, i / 80, i % 80, smem); } }
    else if (it < o4) { if (mask & 4) { int i = it - o3; p0_transpose<false>(p.glu_w, 1024, p.GluT, 1024, i / 16, i % 16, smem); } }
    else if (it < o5) { if (mask & 4) { int i = it - o4; p0_transpose<false>(p.w_out, 1024, p.WoutT, 2048, i / 16, i % 16, smem); } }
    else if (it < o6) { if (mask & 8) p0_bpow(p, it - o5); }
    else if (it < o7) { if (mask & 16) p0_cpow(p, it - o6); }
    else { if (mask & 32) p0_misc(p, it - o7); }
  }
}

template <int MODE>
struct ProbIn {
  static constexpr int NT = 16; static constexpr bool PERM = true, A2 = false, B2 = false;
  Params p; int G, c;
  __device__ __forceinline__ bool next(int i, Unit& u) const {
    if (MODE == 1) { if (i > 0 || c >= 32) return false; u.pm = c >> 2; u.pn = 12 + (c & 3); u.aux = 1; return true; }
    if (MODE == 2) { const int j = i * G + c; if (j >= 32) return false; u.pm = j >> 2; u.pn = 12 + (j & 3); u.aux = 1; return true; }
    const int L = i * G + c;
    if (L < 2560) { static_order<4>(L, 128, 20, u.pm, u.pn); u.aux = 0; return true; }
    return false;
  }
  __device__ __forceinline__ unsigned avoff(int, int R, int C) const { return (unsigned)(R * 1024 + C) * 2u; }
  __device__ __forceinline__ unsigned bvoff(int, int R, int C) const { return (unsigned)(R * 1024 + C) * 2u; }
  __device__ __forceinline__ bool asel(int) const { return false; }
  __device__ __forceinline__ bool bsel(int) const { return false; }
  __device__ __forceinline__ const char* abase(const Unit& u, int h, int kt) const {
    return (const char*)p.Hb + ((size_t)((u.pm + u.aux * 128) * 256 + h * 128) * 1024 + kt * 64) * 2;
  }
  __device__ __forceinline__ const char* bbase(const Unit& u, int h, int kt) const {
    return (const char*)p.WinT + ((size_t)(u.pn * 256 + h * 128) * 1024 + kt * 64) * 2;
  }
  __device__ __forceinline__ void epi(const f32x4 (&acc)[2][2][4][2], const Unit& u, int wr, int wc, int fr, int fq) const {
    const int row0 = u.pm * 256 + wr * 64 + fr;
    if (u.pn < 8) {
      const int ch = u.pn * 128 + wc * 32 + fq * 8;
#pragma unroll
      for (int ai = 0; ai < 2; ++ai)
#pragma unroll
        for (int m = 0; m < 4; ++m) {
          const int r = row0 + ai * 128 + m * 16;
          f32x4 v0, v1;
#pragma unroll
          for (int j = 0; j < 4; ++j) {
            v0[j] = acc[ai][0][m][0][j] * sigmoidf_(acc[ai][1][m][0][j]);
            v1[j] = acc[ai][0][m][1][j] * sigmoidf_(acc[ai][1][m][1][j]);
          }
          *(uint4*)(p.V + (size_t)r * 1024 + ch) = pack8(v0, v1);
        }
    } else if (u.pn < 12 || u.pn >= 16) {
      u16* dstb = p.SGC + ((u.pn < 12) ? (size_t)0 : (size_t)NTOK * 1024);
      const int cb = ((u.pn < 12) ? (u.pn - 8) : (u.pn - 16)) * 256 + wc * 32 + fq * 8;
#pragma unroll
      for (int ai = 0; ai < 2; ++ai)
#pragma unroll
        for (int m = 0; m < 4; ++m) {
          const int r = row0 + ai * 128 + m * 16;
#pragma unroll
          for (int bj = 0; bj < 2; ++bj) {
            f32x4 v0, v1;
#pragma unroll
            for (int j = 0; j < 4; ++j) { v0[j] = siluf_(acc[ai][bj][m][0][j]); v1[j] = siluf_(acc[ai][bj][m][1][j]); }
            *(uint4*)(dstb + (size_t)r * 1024 + cb + bj * 128) = pack8(v0, v1);
          }
        }
    } else {
#pragma unroll
      for (int ai = 0; ai < 2; ++ai)
#pragma unroll
        for (int m = 0; m < 4; ++m) {
          const int r = row0 + ai * 128 + m * 16;
          size_t tokrow;
          if (!u.aux) { int b = r >> 12, l = r & 4095; tokrow = (size_t)b * 4352 + 256 + l; }
          else { int b = r >> 8, l = r & 255; tokrow = (size_t)b * 4352 + l; }
#pragma unroll
          for (int bj = 0; bj < 2; ++bj) {
            const int g = (u.pn - 12) * 16 + bj * 8 + wc * 2 + (fq >> 1);
            *(uint4*)(p.Ug + (size_t)g * UGS + tokrow * 16 + (fq & 1) * 8) = pack8(acc[ai][bj][m][0], acc[ai][bj][m][1]);
          }
        }
    }
  }
};

__device__ __forceinline__ const float* p1_src(const Params& p, int r) {
  return (r < NTOK) ? (p.x + (size_t)r * 1024) : (p.ctx + (size_t)(r - NTOK) * 1024);
}
template <int NQ>
__device__ __forceinline__ void p1_rows(const Params& p, const float4 (&v)[NQ][4], int r0, int lane) {
#pragma unroll
  for (int q = 0; q < NQ; ++q) {
    const int r = r0 + q;
    u16* dst = p.Hb + (size_t)r * 1024;
    const int mrow = (r < NTOK) ? (r >> 12) : 8;
    float ss = 0.f;
#pragma unroll
    for (int i = 0; i < 4; ++i) ss += v[q][i].x * v[q][i].x + v[q][i].y * v[q][i].y + v[q][i].z * v[q][i].z + v[q][i].w * v[q][i].w;
    ss = wave_sum(ss);
    const float rstd = rsqrtf(ss * (1.f / 1024.f) + EPS);
    const float* shift = p.mod + mrow * 3072;
    const float* scale = shift + 1024;
#pragma unroll
    for (int i = 0; i < 4; ++i) {
      const int idx = i * 256 + lane * 4;
      const float4 g = *(const float4*)(p.norm_g + idx);
      const float4 sc = *(const float4*)(scale + idx);
      const float4 sh = *(const float4*)(shift + idx);
      const float h0 = v[q][i].x * rstd * g.x * (1.f + sc.x) + sh.x;
      const float h1 = v[q][i].y * rstd * g.y * (1.f + sc.y) + sh.y;
      const float h2 = v[q][i].z * rstd * g.z * (1.f + sc.z) + sh.z;
      const float h3 = v[q][i].w * rstd * g.w * (1.f + sc.w) + sh.w;
      *(uint2*)(dst + idx) = make_uint2(pack2(h0, h1), pack2(h2, h3));
    }
  }
}
__device__ __forceinline__ int p1_item(int c, int k) {
  if (c < 32) return -1;
  const int it = (c - 32) + k * 224;
  return (it < NTOK / 16) ? it : -1;
}
__device__ void phase1(const Params& p, unsigned char* smem) {
  const int wid = threadIdx.x >> 6, lane = threadIdx.x & 63;
  const int c = blockIdx.x, G = gridDim.x;
  if (G == 256 && c < 32) {
    const int rbase = NTOK + (c >> 2) * 256 + wid * 32;
    {
      float4 v[4][4], vn[4][4];
#pragma unroll
      for (int q = 0; q < 4; ++q) {
        const float* src = p1_src(p, rbase + q);
#pragma unroll
        for (int i = 0; i < 4; ++i) v[q][i] = *(const float4*)(src + i * 256 + lane * 4);
      }
#pragma unroll 1
      for (int j = 0; j < 8; ++j) {
        if (j < 7) {
#pragma unroll
          for (int q = 0; q < 4; ++q) {
            const float* src = p1_src(p, rbase + (j + 1) * 4 + q);
#pragma unroll
            for (int i = 0; i < 4; ++i) vn[q][i] = *(const float4*)(src + i * 256 + lane * 4);
          }
        }
        p1_rows<4>(p, v, rbase + j * 4, lane);
#pragma unroll
        for (int q = 0; q < 4; ++q)
#pragma unroll
          for (int i = 0; i < 4; ++i) v[q][i] = vn[q][i];
      }
    }
    asm volatile("s_waitcnt vmcnt(0)" ::: "memory");
    __threadfence();
    __syncthreads();
    ProbIn<1> P{p, G, c};
    gemm_phase((LAS unsigned char*)smem, P);
  }
  if (G == 256) {
    float4 v[2][4], vn[2][4];
    int k = 0, it = p1_item(c, 0);
    if (it >= 0) {
#pragma unroll
      for (int q = 0; q < 2; ++q) {
        const float* src = p.x + (size_t)(it * 16 + wid * 2 + q) * 1024;
#pragma unroll
        for (int i = 0; i < 4; ++i) v[q][i] = *(const float4*)(src + i * 256 + lane * 4);
      }
    }
    while (it >= 0) {
      const int itn = p1_item(c, ++k);
      if (itn >= 0) {
#pragma unroll
        for (int q = 0; q < 2; ++q) {
          const float* src = p.x + (size_t)(itn * 16 + wid * 2 + q) * 1024;
#pragma unroll
          for (int i = 0; i < 4; ++i) vn[q][i] = *(const float4*)(src + i * 256 + lane * 4);
        }
      }
      p1_rows<2>(p, v, it * 16 + wid * 2, lane);
#pragma unroll
      for (int q = 0; q < 2; ++q)
#pragma unroll
        for (int i = 0; i < 4; ++i) v[q][i] = vn[q][i];
      it = itn;
    }
  } else {
    for (int it = c; it < (NTOK + NCTX) / 16; it += G) {
      float4 v[2][4];
#pragma unroll
      for (int q = 0; q < 2; ++q) {
        const float* src = p1_src(p, it * 16 + wid * 2 + q);
#pragma unroll
        for (int i = 0; i < 4; ++i) v[q][i] = *(const float4*)(src + i * 256 + lane * 4);
      }
      p1_rows<2>(p, v, it * 16 + wid * 2, lane);
    }
  }
}

typedef float f32x2 __attribute__((ext_vector_type(2)));
template <int Q, int QEND>
__device__ __forceinline__ void hconv_step(const f32x2 (&in)[64], const f32x2 (&w)[31], const f32x2 bias, float* dst) {
  f32x2 a = bias;
  constexpr int KLO = (Q < 15) ? (15 - Q) : 0, KHI = (Q > 48) ? (79 - Q) : 31;
#pragma unroll
  for (int k = KLO; k < KHI; ++k) a += in[Q + k - 15] * w[k];
  *(unsigned*)((u16*)(dst + (size_t)Q * 1024)) = pack2(a.x, a.y);
  if constexpr (Q + 1 < QEND) hconv_step<Q + 1, QEND>(in, w, bias, dst);
}
template <bool DRY>
__device__ void p3_conv(const Params& p, int item, unsigned char* smem) {
  int tid_ = threadIdx.x;
  asm volatile("" : "+v"(tid_));
  const int tid = tid_, wid = __builtin_amdgcn_readfirstlane(tid >> 6), lane = tid & 63;
  const int b = item >> 5, r0 = ((item >> 1) & 15) * 4, c0 = (item & 1) * 32;
  const size_t tokb = (size_t)b * 4096;
  float* scrb = p.out + tokb * 1024;
  for (int rep = 0; rep < ((PROBE == 32) ? 2 : 1); ++rep) {
    const int t = tid & 255, sub = tid >> 8;
    const int ch = 512 + t * 2;
    const f32x2 bias = *(const f32x2*)(p.conv_db + ch);
    const int ri_lo = (r0 - 15) > 0 ? (r0 - 15) : 0, ri_hi = (r0 + 18) < 63 ? (r0 + 18) : 63;
    const int nst = ri_hi - ri_lo + 1;
    const int k0 = ri_lo - r0 + 15;
    const u16* vsrc = p.V + (tokb + c0 + wid * 4) * 1024 + 512 + lane * 8;
    LAS unsigned char* lds = (LAS unsigned char*)smem;
    f32x2 acc[4][16];
#pragma unroll
    for (int j = 0; j < 4; ++j)
#pragma unroll
      for (int q = 0; q < 16; ++q) acc[j][q] = bias;
    auto stage = [&](int ri, int slot) {
#pragma unroll
      for (int j = 0; j < 4; ++j)
        __builtin_amdgcn_global_load_lds((const unsigned*)(vsrc + (size_t)(ri * 64 + j) * 1024),
                                         (LAS unsigned*)(lds + slot * 32768 + (wid * 4 + j) * 1024), 16, 0, 0);
    };
    auto wtap = [&](int k) -> f32x2 {
      const int kc = k < 0 ? 0 : (k > 30 ? 30 : k);
      f32x2 w = *(const f32x2*)(p.conv_dw + kc * 1024 + ch);
      if (k < 0 || k > 30) w = (f32x2){0.f, 0.f};
      return w;
    };
    __syncthreads();
    f32x2 w0 = wtap(k0), w1 = wtap(k0 - 1), w2 = wtap(k0 - 2), w3 = wtap(k0 - 3);
    stage(ri_lo, 0);
    asm volatile("" ::: "memory");
    f32x2 wq1 = wtap(k0 + 1); stage(ri_lo + 1, 1);
    asm volatile("" ::: "memory");
    f32x2 wq2 = wtap(k0 + 2); stage(ri_lo + 2, 2);
    asm volatile("" ::: "memory");
#pragma unroll 1
    for (int s = 0; s < nst; ++s) {
      if (s + 2 < nst) asm volatile("s_waitcnt vmcnt(10)" ::: "memory");
      else asm volatile("s_waitcnt vmcnt(0)" ::: "memory");
      __syncthreads();
      f32x2 wn = (f32x2){0.f, 0.f};
      if (s + 3 < nst) { wn = wtap(k0 + s + 3); stage(ri_lo + s + 3, (s + 3) & 3); }
      const LAS unsigned* src = (const LAS unsigned*)(lds + (s & 3) * 32768 + sub * 16384 + t * 4);
#pragma unroll
      for (int q = 0; q < 16; ++q) {
        const unsigned raw = src[q * 256];
        f32x2 v; v.x = bflo(raw); v.y = bfhi(raw);
        acc[0][q] = __builtin_elementwise_fma(v, w0, acc[0][q]); acc[1][q] = __builtin_elementwise_fma(v, w1, acc[1][q]);
        acc[2][q] = __builtin_elementwise_fma(v, w2, acc[2][q]); acc[3][q] = __builtin_elementwise_fma(v, w3, acc[3][q]);
      }
      w3 = w2; w2 = w1; w1 = w0; w0 = wq1; wq1 = wq2; wq2 = wn;
    }
#pragma unroll
    for (int j = 0; j < 4; ++j)
#pragma unroll
      for (int q = 0; q < 16; ++q)
        *(unsigned*)((u16*)(scrb + (size_t)((r0 + j) * 64 + c0 + sub * 16 + q) * 1024) + ch) = pack2(acc[j][q].x, acc[j][q].y);
  }
  for (int rep = 0; rep < ((PROBE == 33) ? 2 : 1); ++rep) {
    const int t = tid & 255, rsel = tid >> 8;
    const int ch = t * 2;
    const f32x2 bias = *(const f32x2*)(p.conv_db + ch);
    f32x2 w[31];
#pragma unroll
    for (int k = 0; k < 31; ++k) w[k] = *(const f32x2*)(p.conv_dw + k * 1024 + ch);
#pragma unroll 1
    for (int rr = 0; rr < 2; ++rr) {
      const int row = r0 + rsel * 2 + rr;
      f32x2 in[64];
      {
        const u16* vrow = p.V + (tokb + row * 64) * 1024 + ch;
        unsigned raw[64];
#pragma unroll
        for (int q = 0; q < 64; ++q) raw[q] = *(const unsigned*)(vrow + (size_t)q * 1024);
#pragma unroll
        for (int q = 0; q < 64; ++q) { in[q].x = bflo(raw[q]); in[q].y = bfhi(raw[q]); }
      }
      float* dst = (float*)((u16*)(scrb + (size_t)(row * 64) * 1024) + ch);
      if (c0 == 0) hconv_step<0, 32>(in, w, bias, dst);
      else hconv_step<32, 64>(in, w, bias, dst);
    }
  }
  __syncthreads();
  float4 v[4][4], vn[4][4]; uint2 gt[4][4], gtn[4][4];
  auto ln_load = [&](int qb, float4 (&vv)[4][4], uint2 (&gg)[4][4]) {
#pragma unroll
    for (int u = 0; u < 4; ++u) {
      const int tk = wid * 16 + qb * 4 + u;
      const size_t tok = tokb + (r0 + (tk >> 5)) * 64 + c0 + (tk & 31);
      const float* src = p.out + tok * 1024;
      const u16* gd = p.SGC + tok * 1024;
#pragma unroll
      for (int i = 0; i < 4; ++i) {
        const uint2 raw = *(const uint2*)((const u16*)src + i * 256 + lane * 4);
        vv[u][i] = make_float4(bflo(raw.x), bfhi(raw.x), bflo(raw.y), bfhi(raw.y));
        gg[u][i] = *(const uint2*)(gd + i * 256 + lane * 4);
      }
    }
  };
  ln_load(0, v, gt);
#pragma unroll 1
  for (int qb = 0; qb < 4; ++qb) {
    if (qb < 3) ln_load(qb + 1, vn, gtn);
    float s1[4], s2[4];
#pragma unroll
    for (int u = 0; u < 4; ++u) {
      float a = 0.f, q = 0.f;
#pragma unroll
      for (int i = 0; i < 4; ++i) {
        a += (v[u][i].x + v[u][i].y) + (v[u][i].z + v[u][i].w);
        q += (v[u][i].x * v[u][i].x + v[u][i].y * v[u][i].y) + (v[u][i].z * v[u][i].z + v[u][i].w * v[u][i].w);
      }
      s1[u] = a; s2[u] = q;
    }
#pragma unroll
    for (int u = 0; u < 4; ++u) { s1[u] = wave_sum_fast(s1[u]); s2[u] = wave_sum_fast(s2[u]); }
#pragma unroll
    for (int u = 0; u < 4; ++u) {
      const int tk = wid * 16 + qb * 4 + u;
      const size_t tok = tokb + (r0 + (tk >> 5)) * 64 + c0 + (tk & 31);
      u16* gd = p.SGC + tok * 1024;
      const float mu = s1[u] * (1.f / 1024.f);
      const float var = fmaxf(s2[u] * (1.f / 1024.f) - mu * mu, 0.f);
      const float rstd = rsqrtf(var + EPS);
#pragma unroll
      for (int i = 0; i < 4; ++i) {
        const int idx = i * 256 + lane * 4;
        const float4 lgi = *(const float4*)(p.conv_ln_g + idx), lbi = *(const float4*)(p.conv_ln_b + idx);
        const float y0 = siluf_((v[u][i].x - mu) * rstd * lgi.x + lbi.x) * bflo(gt[u][i].x);
        const float y1 = siluf_((v[u][i].y - mu) * rstd * lgi.y + lbi.y) * bfhi(gt[u][i].x);
        const float y2 = siluf_((v[u][i].z - mu) * rstd * lgi.z + lbi.z) * bflo(gt[u][i].y);
        const float y3 = siluf_((v[u][i].w - mu) * rstd * lgi.w + lbi.w) * bfhi(gt[u][i].y);
        if (DRY) *(uint2*)((u16*)(p.out + tok * 1024) + idx) = make_uint2(pack2(y0, y1), pack2(y2, y3));
        else *(uint2*)(gd + idx) = make_uint2(pack2(y0, y1), pack2(y2, y3));
      }
    }
#pragma unroll
    for (int u = 0; u < 4; ++u)
#pragma unroll
      for (int i = 0; i < 4; ++i) { v[u][i] = vn[u][i]; gt[u][i] = gtn[u][i]; }
  }
}

struct ProbS {
  static constexpr int NT = 16; static constexpr bool PERM = false, A2 = false, B2 = false;
  Params p; int G, c;
  __device__ __forceinline__ bool next(int i, Unit& u) const {
    if (G == 256) {
      if (i > 0 || c >= 192) return false;
      const int j = c >> 3;
      u.aux = (j / 3) * 8 + (c & 7); u.pm = j % 3; u.pn = 0; return true;
    }
    const int L = i * G + c;
    if (L >= 192) return false;
    u.aux = L / 3; u.pm = L % 3; u.pn = 0; return true;
  }
  __device__ __forceinline__ unsigned avoff(int, int R, int C) const { return (unsigned)(R * 1024 + C) * 2u; }
  __device__ __forceinline__ unsigned bvoff(int, int R, int C) const { return (unsigned)(R * 1024 + C) * 2u; }
  __device__ __forceinline__ bool asel(int) const { return false; }
  __device__ __forceinline__ bool bsel(int) const { return false; }
  __device__ __forceinline__ const char* abase(const Unit& u, int h, int kt) const {
    return (const char*)p.Ug + ((size_t)u.aux * UGS + (size_t)(u.pm * 256 + h * 128) * 1024 + kt * 64) * 2;
  }
  __device__ __forceinline__ const char* bbase(const Unit& u, int h, int kt) const {
    return (const char*)p.BpowT + ((size_t)(h * 64 + u.aux) * 128 * 1024 + kt * 64) * 2;
  }
  __device__ __forceinline__ void epi(const f32x4 (&acc)[2][2][4][2], const Unit& u, int wr, int wc, int fr, int fq) const {
#pragma unroll
    for (int ai = 0; ai < 2; ++ai)
#pragma unroll
      for (int m = 0; m < 4; ++m) {
        const int row = u.pm * 256 + ai * 128 + wr * 64 + m * 16 + fr;
        if (row < UROWS) {
#pragma unroll
          for (int bj = 0; bj < 2; ++bj)
#pragma unroll
            for (int n = 0; n < 2; ++n)
              *(f32x4*)(p.S + ((size_t)(bj * 64 + u.aux) * UROWS + row) * 128 + wc * 32 + n * 16 + fq * 4) = acc[ai][bj][m][n];
        }
      }
  }
};

template <bool DRY>
__device__ void phase3(const Params& p, unsigned char* smem) {
  for (int rep = 0; rep < ((PROBE == 31) ? 2 : 1); ++rep) {
    ProbS P{p, (int)gridDim.x, (int)blockIdx.x};
    gemm_phase(( LAS unsigned char*)smem, P);
  }
  if (gridDim.x == 256) {
    const int c = blockIdx.x;
    const int j = c >> 3;
    p3_conv<DRY>(p, (c & 7) * 32 + j, smem);
    return;
  }
  int* sh_item = (int*)(smem + STAGE_BYTES);
  for (;;) {
    __syncthreads();
    if (threadIdx.x == 0) *sh_item = atomicAdd(p.ctr + (DRY ? 1 : 0), 1);
    __syncthreads();
    const int item = *sh_item;
    if (item >= 256) break;
    p3_conv<DRY>(p, item, smem);
  }
}

__device__ void phase4(const Params& p) {
  const int tid = threadIdx.x;
  for (int it = blockIdx.x; it < 256; it += gridDim.x) {
    if (tid >= 256) continue;
    int idx = it * 4 + (tid >> 6), pp = tid & 63;
    int d = idx >> 9, b = (idx >> 6) & 7, g = idx & 63;
    int dg = d * 64 + g;
    float lr = p.lam64[(dg * 64 + pp) * 2], li = p.lam64[(dg * 64 + pp) * 2 + 1];
    float hr = 0.f, hi = 0.f;
    const float* Sb = p.S + ((size_t)dg * UROWS + b * NCH) * 128;
    u16* Hb = p.Hp + ((size_t)g * 512 + b * 64) * 256 + d * 128;
#pragma unroll 1
    for (int cb = 0; cb < 4; ++cb) {
      float sr[17], si[17];
#pragma unroll
      for (int j = 0; j < 17; ++j) {
        const int step = cb * 17 + j;
        const int c = (d == 0) ? step : (step < 4 ? 3 - step : 71 - step);
        sr[j] = Sb[(size_t)c * 128 + pp]; si[j] = Sb[(size_t)c * 128 + 64 + pp];
      }
#pragma unroll
      for (int j = 0; j < 17; ++j) {
        const int step = cb * 17 + j;
        const int c = (d == 0) ? step : (step < 4 ? 3 - step : 71 - step);
        if (c >= 4) {
          Hb[(size_t)(c - 4) * 256 + pp] = f2bf(hr);
          Hb[(size_t)(c - 4) * 256 + 64 + pp] = f2bf(hi);
        }
        const float nr = lr * hr - li * hi + sr[j];
        const float ni = lr * hi + li * hr + si[j];
        hr = nr; hi = ni;
      }
    }
  }
}

struct ProbY {
  static constexpr int NT = 20; static constexpr bool PERM = true, A2 = true, B2 = true;
  Params p; int G, c;
  __device__ __forceinline__ bool next(int i, Unit& u) const {
    if (G == 256) {
      if (i > 1) return false;
      const int x = c & 7, j = c >> 3;
      u.aux = i * 32 + x * 4 + (j >> 3); u.pm = (j >> 2) & 1; u.pn = j & 3; return true;
    }
    const int L = i * G + c;
    if (L >= 512) return false;
    u.aux = L >> 3; u.pm = (L >> 2) & 1; u.pn = L & 3; return true;
  }
  __device__ __forceinline__ unsigned avoff(int s, int R, int C) const {
    return s ? (unsigned)(R * 256 + C) * 2u : (unsigned)(((R >> 6) * NCH + (R & 63)) * 1024 + C) * 2u;
  }
  __device__ __forceinline__ unsigned bvoff(int s, int R, int C) const {
    return s ? (unsigned)(R * 256 + C) * 2u : (unsigned)(((R >> 4) - (C >> 4) + 3) * 256 + (R & 15) * 16 + (C & 15)) * 2u;
  }
  __device__ __forceinline__ bool asel(int kt) const { return kt >= 16; }
  __device__ __forceinline__ bool bsel(int kt) const { return kt >= 16; }
  __device__ __forceinline__ const char* abase(const Unit& u, int h, int kt) const {
    if (kt < 16) return (const char*)p.Ug + ((size_t)u.aux * UGS + (size_t)((u.pm * 4 + h * 2) * NCH + 4) * 1024 + kt * 64) * 2;
    return (const char*)p.Hp + (((size_t)u.aux * 512 + u.pm * 256 + h * 128) * 256 + (kt - 16) * 64) * 2;
  }
  __device__ __forceinline__ const char* bbase(const Unit& u, int h, int kt) const {
    if (kt < 16) return (const char*)p.Kc + ((size_t)u.aux * 128 * 256 + (size_t)(u.pn * 16 + h * 8 - kt * 4 + 60) * 256) * 2;
    return (const char*)p.CpowT + (((size_t)u.aux * 1024 + u.pn * 256 + h * 128) * 256 + (kt - 16) * 64) * 2;
  }
  __device__ __forceinline__ void epi(const f32x4 (&acc)[2][2][4][2], const Unit& u, int wr, int wc, int fr, int fq) const {
    u16* Yact = p.Hb;
#pragma unroll
    for (int ai = 0; ai < 2; ++ai)
#pragma unroll
      for (int m = 0; m < 4; ++m) {
        const int rr = u.pm * 256 + ai * 128 + wr * 64 + m * 16 + fr;
        const int b = rr >> 6, cc = rr & 63;
#pragma unroll
        for (int bj = 0; bj < 2; ++bj) {
          const int t = u.pn * 16 + bj * 8 + wc * 2 + (fq >> 1);
          const size_t tok = (size_t)b * 4096 + cc * 64 + t;
          f32x4 v0, v1;
#pragma unroll
          for (int j = 0; j < 4; ++j) { v0[j] = gelu_tanh(acc[ai][bj][m][0][j]); v1[j] = gelu_tanh(acc[ai][bj][m][1][j]); }
          *(uint4*)(Yact + tok * 1024 + u.aux * 16 + (fq & 1) * 8) = pack8(v0, v1);
        }
      }
  }
};

template <bool DRY>
struct ProbGlu {
  static constexpr int NT = 16; static constexpr bool PERM = true, A2 = false, B2 = false;
  Params p; int G, c;
  __device__ __forceinline__ bool next(int i, Unit& u) const {
    const int L = i * G + c;
    if (L >= 512) return false;
    static_order(L, 128, 4, u.pm, u.pn); u.aux = 0; return true;
  }
  __device__ __forceinline__ unsigned avoff(int, int R, int C) const { return (unsigned)(R * 1024 + C) * 2u; }
  __device__ __forceinline__ unsigned bvoff(int, int R, int C) const { return (unsigned)(R * 1024 + C) * 2u; }
  __device__ __forceinline__ bool asel(int) const { return false; }
  __device__ __forceinline__ bool bsel(int) const { return false; }
  __device__ __forceinline__ const char* abase(const Unit& u, int h, int kt) const {
    return (const char*)p.Hb + ((size_t)(u.pm * 256 + h * 128) * 1024 + kt * 64) * 2;
  }
  __device__ __forceinline__ const char* bbase(const Unit& u, int h, int kt) const {
    return (const char*)p.GluT + ((size_t)(u.pn * 256 + h * 128) * 1024 + kt * 64) * 2;
  }
  __device__ __forceinline__ void epi(const f32x4 (&acc)[2][2][4][2], const Unit& u, int wr, int wc, int fr, int fq) const {
    const u16* Yact = p.Hb;
#pragma unroll
    for (int bj = 0; bj < 2; ++bj) {
      const int c0 = u.pn * 256 + bj * 128 + wc * 32 + fq * 8;
      const f32x4 gb0 = *(const f32x4*)(p.glu_b + c0), gb1 = *(const f32x4*)(p.glu_b + c0 + 4);
#pragma unroll
      for (int ai = 0; ai < 2; ++ai)
#pragma unroll
        for (int m = 0; m < 4; ++m) {
          const int r = u.pm * 256 + ai * 128 + wr * 64 + m * 16 + fr;
          const uint4 y = *(const uint4*)(Yact + (size_t)r * 1024 + c0);
          const uint4 s = *(const uint4*)(p.SGS + (size_t)r * 1024 + c0);
          const f32x4 a0 = acc[ai][bj][m][0] + gb0, a1 = acc[ai][bj][m][1] + gb1;
          f32x4 o0, o1;
          o0[0] = bflo(y.x) * sigmoidf_(a0[0]) * bflo(s.x); o0[1] = bfhi(y.x) * sigmoidf_(a0[1]) * bfhi(s.x);
          o0[2] = bflo(y.y) * sigmoidf_(a0[2]) * bflo(s.y); o0[3] = bfhi(y.y) * sigmoidf_(a0[3]) * bfhi(s.y);
          o1[0] = bflo(y.z) * sigmoidf_(a1[0]) * bflo(s.z); o1[1] = bfhi(y.z) * sigmoidf_(a1[1]) * bfhi(s.z);
          o1[2] = bflo(y.w) * sigmoidf_(a1[2]) * bflo(s.w); o1[3] = bfhi(y.w) * sigmoidf_(a1[3]) * bfhi(s.w);
          *(uint4*)((DRY ? p.V : p.SGS) + (size_t)r * 1024 + c0) = pack8(o0, o1);
        }
    }
  }
};

template <bool DRY>
struct ProbOut {
  static constexpr int NT = 32; static constexpr bool PERM = false, A2 = false, B2 = false;
  Params p; int G, c;
  __device__ __forceinline__ bool next(int i, Unit& u) const {
    const int L = i * G + c;
    if (L >= 512) return false;
    static_order(L, 128, 4, u.pm, u.pn); u.aux = 0; return true;
  }
  __device__ __forceinline__ unsigned avoff(int, int R, int C) const { return (unsigned)(R * 1024 + C) * 2u; }
  __device__ __forceinline__ unsigned bvoff(int, int R, int C) const { return (unsigned)(R * 2048 + C) * 2u; }
  __device__ __forceinline__ bool asel(int) const { return false; }
  __device__ __forceinline__ bool bsel(int) const { return false; }
  __device__ __forceinline__ const char* abase(const Unit& u, int h, int kt) const {
    return (const char*)p.SGC + (size_t)(kt >> 4) * NTOK * 1024 * 2 + ((size_t)(u.pm * 256 + h * 128) * 1024 + (kt & 15) * 64) * 2;
  }
  __device__ __forceinline__ const char* bbase(const Unit& u, int h, int kt) const {
    return (const char*)p.WoutT + ((size_t)(u.pn * 256 + h * 128) * 2048 + kt * 64) * 2;
  }
  bool fused;
  __device__ __forceinline__ void epi(f32x4 (&acc)[2][2][4][2], const Unit& u, int wr, int wc, int fr, int fq) const {
    const int col0 = u.pn * 256 + wc * 32 + fq * 4;
    {
      const float* gate = p.mod + ((u.pm * 256) >> 12) * 3072 + 2048 + col0;
      f32x4 gt[2][2];
#pragma unroll
      for (int bj = 0; bj < 2; ++bj)
#pragma unroll
        for (int n = 0; n < 2; ++n) gt[bj][n] = *(const f32x4*)(gate + bj * 128 + n * 16);
#pragma unroll
      for (int ai = 0; ai < 2; ++ai)
#pragma unroll
        for (int m = 0; m < 4; ++m) {
          const int r = u.pm * 256 + ai * 128 + wr * 64 + m * 16 + fr;
          const size_t off = (size_t)r * 1024 + col0;
          float sq = 0.f;
#pragma unroll
          for (int bj = 0; bj < 2; ++bj)
#pragma unroll
            for (int n = 0; n < 2; ++n) {
              const f32x4 xv = *(const f32x4*)(p.x + off + bj * 128 + n * 16);
              const f32x4 o = xv + gt[bj][n] * acc[ai][bj][m][n];
              sq += (o[0] * o[0] + o[1] * o[1]) + (o[2] * o[2] + o[3] * o[3]);
              if (DRY || !fused) *(f32x4*)(p.out + off + bj * 128 + n * 16) = o;
              else acc[ai][bj][m][n] = o;
            }
          sq += __shfl_xor(sq, 16);
          sq += __shfl_xor(sq, 32);
          if (fq == 0) { const float prev = atomicAdd((DRY ? p.S : p.rowsq) + r, sq); asm volatile("" :: "v"(prev)); }
        }
    }
    if (DRY || !fused) return;
    unsigned* cnt = (unsigned*)p.ctr + 256 + u.pm * 16 + wr * 8;
    asm volatile("s_waitcnt vmcnt(0)" ::: "memory");
    if ((threadIdx.x & 63) == 0) (void)__hip_atomic_fetch_add(cnt, 1u, __ATOMIC_RELAXED, __HIP_MEMORY_SCOPE_AGENT);
    {
      unsigned sp = 0;
      while ((unsigned)__builtin_amdgcn_readfirstlane(__hip_atomic_load(cnt, __ATOMIC_RELAXED, __HIP_MEMORY_SCOPE_AGENT)) < 16u) {
        __builtin_amdgcn_s_sleep(1);
        if (++sp > (1u << 16)) break;
      }
    }
    {
      f32x4 fg[2][2];
#pragma unroll
      for (int bj = 0; bj < 2; ++bj)
#pragma unroll
        for (int n = 0; n < 2; ++n) fg[bj][n] = *(const f32x4*)(p.final_g + col0 + bj * 128 + n * 16);
#pragma unroll
      for (int ai = 0; ai < 2; ++ai)
#pragma unroll
        for (int m = 0; m < 4; ++m) {
          const int r = u.pm * 256 + ai * 128 + wr * 64 + m * 16 + fr;
          const size_t off = (size_t)r * 1024 + col0;
          const float tot = __uint_as_float(__hip_atomic_load((unsigned*)(p.rowsq + r), __ATOMIC_RELAXED, __HIP_MEMORY_SCOPE_AGENT));
          const float rs = rsqrtf(tot * (1.f / 1024.f) + EPS);
#pragma unroll
          for (int bj = 0; bj < 2; ++bj)
#pragma unroll
            for (int n = 0; n < 2; ++n) *(f32x4*)(p.out + off + bj * 128 + n * 16) = acc[ai][bj][m][n] * rs * fg[bj][n];
        }
    }
  }
};

template <bool DRY>
__device__ void phase8(const Params& p) {
  const int wid = threadIdx.x >> 6, lane = threadIdx.x & 63;
  constexpr int NIT = NTOK / 16;
  float4 v[2][4], vn[2][4];
  int it = blockIdx.x;
  if (it < NIT) {
#pragma unroll
    for (int q = 0; q < 2; ++q) {
      const float* row = p.out + (size_t)(it * 16 + wid * 2 + q) * 1024;
#pragma unroll
      for (int i = 0; i < 4; ++i) v[q][i] = *(const float4*)(row + i * 256 + lane * 4);
    }
  }
  for (; it < NIT; it += gridDim.x) {
    const int itn = it + gridDim.x;
    if (itn < NIT) {
#pragma unroll
      for (int q = 0; q < 2; ++q) {
        const float* row = p.out + (size_t)(itn * 16 + wid * 2 + q) * 1024;
#pragma unroll
        for (int i = 0; i < 4; ++i) vn[q][i] = *(const float4*)(row + i * 256 + lane * 4);
      }
    }
#pragma unroll
    for (int q = 0; q < 2; ++q) {
      const int r = it * 16 + wid * 2 + q;
      float rstd = DRY ? (p.rowsq[r] < -1.f ? 2.f : 1.f) : rsqrtf(p.rowsq[r] * (1.f / 1024.f) + EPS);
      float* row = p.out + (size_t)r * 1024;
#pragma unroll
      for (int i = 0; i < 4; ++i) {
        const int idx = i * 256 + lane * 4;
        float4 g = *(const float4*)(p.final_g + idx);
        if (DRY) g = make_float4(g.x < -100.f ? 2.f : 1.f, g.y < -100.f ? 2.f : 1.f, g.z < -100.f ? 2.f : 1.f, g.w < -100.f ? 2.f : 1.f);
        const float4 w = v[q][i];
        *(float4*)(row + idx) = make_float4(w.x * rstd * g.x, w.y * rstd * g.y, w.z * rstd * g.z, w.w * rstd * g.w);
      }
    }
#pragma unroll
    for (int q = 0; q < 2; ++q)
#pragma unroll
      for (int i = 0; i < 4; ++i) v[q][i] = vn[q][i];
  }
}

__global__ void __launch_bounds__(512, 2) mega_kernel(Params p) {
  extern __shared__ __attribute__((aligned(16))) unsigned char smem[];
  cg::grid_group grid = cg::this_grid();
  const int G = (int)gridDim.x, c = (int)blockIdx.x;
  volatile LAS unsigned* xst = (volatile LAS unsigned*)((LAS unsigned char*)smem + STAGE_BYTES + 16);
  if (threadIdx.x == 0) { xst[0] = 0u; xst[1] = 0u; }
  __syncthreads();
  const XcdBarrier xb = xcd_barrier_post(p.bar, xst);
#define GSYNC() xcd_barrier(xb)
  if (PROBE == 0) { phase0(p, smem); GSYNC(); }
  if (PROBE >= 10 && PROBE < 20) { phase0(p, smem, 1 << (PROBE - 10)); GSYNC(); }
  phase0(p, smem);
  if (p.bar == nullptr) grid.sync();
  GSYNC();
  if (PROBE == 1) { phase1(p, smem); GSYNC(); }
  phase1(p, smem); GSYNC();
  if (PROBE == 2) { ProbIn<0> P{p, G, c}; gemm_phase((LAS unsigned char*)smem, P); GSYNC(); }
  { ProbIn<0> P{p, G, c}; gemm_phase((LAS unsigned char*)smem, P); }
  if (G != 256) { ProbIn<2> P{p, G, c}; gemm_phase((LAS unsigned char*)smem, P); }
  GSYNC();
  if (PROBE == 3) { phase3<true>(p, smem); GSYNC(); }
  phase3<false>(p, smem); GSYNC();
  if (PROBE == 4) { phase4(p); GSYNC(); }
  phase4(p); GSYNC();
  if (PROBE == 5) { ProbY P{p, G, c}; gemm_phase((LAS unsigned char*)smem, P); GSYNC(); }
  { ProbY P{p, G, c}; gemm_phase((LAS unsigned char*)smem, P); } GSYNC();
  if (PROBE == 6) { ProbGlu<true> P{p, G, c}; gemm_phase((LAS unsigned char*)smem, P); GSYNC(); }
  { ProbGlu<false> P{p, G, c}; gemm_phase((LAS unsigned char*)smem, P); } GSYNC();
  const bool fused = (G == 256);
  if (PROBE == 7) { ProbOut<true> P{p, G, c, fused}; gemm_phase((LAS unsigned char*)smem, P); GSYNC(); }
  if (PROBE == 9) { GSYNC(); GSYNC(); GSYNC(); GSYNC(); GSYNC(); GSYNC(); GSYNC(); GSYNC(); }
  { ProbOut<false> P{p, G, c, fused}; gemm_phase((LAS unsigned char*)smem, P); }
  if (!fused) { GSYNC(); phase8<false>(p); }
}

static size_t align_up(size_t v) { return (v + 255) & ~(size_t)255; }
constexpr int LDS_BYTES = STAGE_BYTES + 256;

extern "C" void kernel_launch(void* const* d_in, const int* in_sizes, int n_in, void* d_out, int out_size, void* d_ws,
                              size_t ws_size, hipStream_t stream) {
  Params p{};
  const float** pin = (const float**)&p;
  for (int i = 0; i < 24; ++i) pin[i] = (const float*)d_in[i];
  p.out = (float*)d_out;
  unsigned char* w = (unsigned char*)d_ws;
  size_t off = 0;
  auto take = [&](size_t bytes) { unsigned char* r = w + off; off = align_up(off + bytes); return r; };
  p.mod = (float*)take(9 * 3072 * 4);
  p.rowsq = (float*)take((size_t)NTOK * 4);
  p.ctr = (int*)take(16384);
  p.bar = (unsigned*)take(XCD_BAR_WORDS * 4);
  p.lam64 = (float*)take(2 * 64 * 64 * 2 * 4);
  p.WinT = (u16*)take((size_t)5120 * 1024 * 2);
  p.GluT = (u16*)take((size_t)1024 * 1024 * 2);
  p.WoutT = (u16*)take((size_t)1024 * 2048 * 2);
  p.BpowT = (u16*)take((size_t)2 * 64 * 128 * 1024 * 2);
  p.CpowT = (u16*)take((size_t)64 * 1024 * 256 * 2);
  p.Kc = (u16*)take((size_t)64 * 128 * 256 * 2);
  p.Hb = (u16*)take((size_t)(NTOK + NCTX) * 1024 * 2);
  p.Hc = p.Hb + (size_t)NTOK * 1024;
  p.V = (u16*)take((size_t)NTOK * 1024 * 2);
  p.SGC = (u16*)take((size_t)NTOK * 1024 * 2 * 2);
  p.SGS = p.SGC + (size_t)NTOK * 1024;
  p.Ug = (u16*)take((size_t)64 * UGS * 2);
  p.S = (float*)take((size_t)2 * 64 * UROWS * 128 * 4);
  p.Hp = (u16*)take((size_t)64 * 512 * 256 * 2);
  if (off > ws_size) { fprintf(stderr, "kernel_launch: workspace too small: need %zu have %zu\n", off, ws_size); return; }
  static int grid = 0;
  if (!grid) {
    int dev = 0, cus = 0, per_cu = 0;
    hipGetDevice(&dev);
    hipDeviceGetAttribute(&cus, hipDeviceAttributeMultiprocessorCount, dev);
    hipFuncSetAttribute((const void*)mega_kernel, hipFuncAttributeMaxDynamicSharedMemorySize, LDS_BYTES);
    hipOccupancyMaxActiveBlocksPerMultiprocessor(&per_cu, (const void*)mega_kernel, 512, LDS_BYTES);
    (void)hipGetLastError();
    grid = cus;
  }
  (void)hipMemsetAsync(p.bar, 0, XCD_BAR_WORDS * 4, stream);
  void* args[] = {&p};
  hipError_t e = hipLaunchCooperativeKernel((const void*)mega_kernel, dim3(grid), dim3(512), args, LDS_BYTES, stream);
  if (e != hipSuccess) fprintf(stderr, "cooperative launch failed: %s (grid %d)\n", hipGetErrorString(e), grid);
}
```
